# Optimizing an MI355X kernel written in HIP

```python
import jax, jax.numpy as jnp
from jax import lax
import numpy as np

D_MODEL = 1024
BATCH = 8
SEQ = 2048
DEPTH = 4

N_MIX = 2
N_RWKV = (DEPTH + 1) // 2
N_ATTN = DEPTH // 2
N_VRES = max(N_RWKV - 1, 0)
RWKV_HEAD = 64
RWKV_HEADS = D_MODEL // RWKV_HEAD
DECAY_LORA = 64
ICLR_LORA = 64
VRES_LORA = 32
GATE_LORA = 128
GN_EPS = 64e-5
HEAD_DIM = 64
N_Q_HEADS = D_MODEL // HEAD_DIM
N_KV_HEADS = 4
GROUP = N_Q_HEADS // N_KV_HEADS
QKV_DIM = (N_Q_HEADS + 2 * N_KV_HEADS) * HEAD_DIM
WINDOW = 128
BLOCK = 128
ROPE_THETA = 500000.0
ROPE_DIM = HEAD_DIM // 4
D_FF = ((8 * D_MODEL // 3 + 255) // 256) * 256
RMS_EPS = 1e-6

kernel_name = "hybrid_rwkv7_swa_sink_swiglu_sandwich"


def rmsnorm(x, g):
    xf = x.astype(jnp.float32)
    y = xf * lax.rsqrt(jnp.mean(xf * xf, axis=-1, keepdims=True) + RMS_EPS)
    return (y * g.astype(jnp.float32)).astype(x.dtype)


def wkv7_scan(r, decay, k, v, a, b):
    Bsz, _, H, N = r.shape
    xs = tuple(jnp.moveaxis(t, 1, 0) for t in (r, decay, k, v, a, b))

    def step(S, inp):
        r_t, w_t, k_t, v_t, a_t, b_t = inp
        sa = jnp.einsum('bhvk,bhk->bhv', S, a_t)
        S = S * w_t[:, :, None, :] + sa[..., None] * b_t[:, :, None, :] + v_t[..., None] * k_t[:, :, None, :]
        y = jnp.einsum('bhvk,bhk->bhv', S, r_t)
        return S, y

    S0 = jnp.zeros((Bsz, H, N, N), jnp.float32)
    _, ys = lax.scan(step, S0, xs)
    return jnp.moveaxis(ys, 0, 1)


def rwkv7_time_mix(x, v_first, x_mix, w_rkv, w0, w1, w2, a0, a1, a2, g1, g2,
                   k_k, k_a, r_k, lnx_w, lnx_b, w_o, vres):
    Bsz, T, C = x.shape
    H, N = RWKV_HEADS, RWKV_HEAD
    f32 = jnp.float32
    x_prev = jnp.pad(x, ((0, 0), (1, 0), (0, 0)))[:, :-1]
    xx = x_prev - x
    xm = x[:, :, None, :] + xx[:, :, None, :] * x_mix
    rkv = jnp.einsum('btjc,jcd->btjd', xm[:, :, :3], w_rkv)
    r, k, v = rkv[:, :, 0], rkv[:, :, 1], rkv[:, :, 2]
    xv, xw, xa, xg = xm[:, :, 2], xm[:, :, 3], xm[:, :, 4], xm[:, :, 5]

    w_log = -jax.nn.softplus(-(w0 + jnp.tanh(xw @ w1) @ w2).astype(f32)) - 0.5
    if vres is None:
        v_first = v
    else:
        v0, v1, v2 = vres
        v = v + (v_first - v) * jax.nn.sigmoid(v0 + (xv @ v1) @ v2)
    a = jax.nn.sigmoid(a0 + (xa @ a1) @ a2)
    g = jax.nn.sigmoid(xg @ g1) @ g2

    kk = (k * k_k).reshape(Bsz, T, H, N).astype(f32)
    kk = kk / jnp.maximum(jnp.sqrt(jnp.sum(kk * kk, -1, keepdims=True)), 1e-12)
    k = k * (1 + (a - 1) * k_a)

    rh = r.reshape(Bsz, T, H, N).astype(f32)
    kh = k.reshape(Bsz, T, H, N).astype(f32)
    vh = v.reshape(Bsz, T, H, N).astype(f32)
    ah = a.reshape(Bsz, T, H, N).astype(f32)
    decay = jnp.exp(-jnp.exp(w_log)).reshape(Bsz, T, H, N)
    y = wkv7_scan(rh, decay, kh, vh, -kk, kk * ah)

    mu = jnp.mean(y, -1, keepdims=True)
    var = jnp.mean(jnp.square(y - mu), -1, keepdims=True)
    y = ((y - mu) * lax.rsqrt(var + GN_EPS)).reshape(Bsz, T, C)
    y = y * lnx_w.astype(f32) + lnx_b.astype(f32)
    bonus = jnp.sum(rh * kh * r_k.astype(f32), -1, keepdims=True) * vh
    y = (y + bonus.reshape(Bsz, T, C)).astype(x.dtype)
    return (y * g) @ w_o, v_first


def rope_tables(T):
    pos = jnp.arange(T, dtype=jnp.float32)
    inv_freq = ROPE_THETA ** (-jnp.arange(0, ROPE_DIM, 2, dtype=jnp.float32) / ROPE_DIM)
    ang = pos[:, None] * inv_freq[None, :]
    return jnp.cos(ang), jnp.sin(ang)


def apply_partial_rope(t, cos, sin):
    tr = t[..., :ROPE_DIM].astype(jnp.float32)
    t1, t2 = tr[..., :ROPE_DIM // 2], tr[..., ROPE_DIM // 2:]
    c, s = cos[None, :, None, :], sin[None, :, None, :]
    rot = jnp.concatenate([t1 * c - t2 * s, t2 * c + t1 * s], axis=-1)
    return jnp.concatenate([rot.astype(t.dtype), t[..., ROPE_DIM:]], axis=-1)


def swa_sink_attention(x, w_qkv, b_qkv, sinks, w_o, b_o, cos, sin):
    Bsz, T, C = x.shape
    nb = T // BLOCK
    qkv = x @ w_qkv + b_qkv
    q = qkv[..., :N_Q_HEADS * HEAD_DIM].reshape(Bsz, T, N_Q_HEADS, HEAD_DIM)
    k = qkv[..., N_Q_HEADS * HEAD_DIM:(N_Q_HEADS + N_KV_HEADS) * HEAD_DIM].reshape(Bsz, T, N_KV_HEADS, HEAD_DIM)
    v = qkv[..., (N_Q_HEADS + N_KV_HEADS) * HEAD_DIM:].reshape(Bsz, T, N_KV_HEADS, HEAD_DIM)
    q = apply_partial_rope(q, cos, sin)
    k = apply_partial_rope(k, cos, sin)

    q = q.reshape(Bsz, nb, BLOCK, N_KV_HEADS, GROUP, HEAD_DIM)
    k = k.reshape(Bsz, nb, BLOCK, N_KV_HEADS, HEAD_DIM)
    v = v.reshape(Bsz, nb, BLOCK, N_KV_HEADS, HEAD_DIM)

    def with_prev(t):
        prev = jnp.pad(t, ((0, 0), (1, 0), (0, 0), (0, 0), (0, 0)))[:, :-1]
        return jnp.concatenate([prev, t], axis=2)

    kb, vb = with_prev(k), with_prev(v)
    s = jnp.einsum('bnqhgd,bnkhd->bnhgqk', q, kb).astype(jnp.float32) * (HEAD_DIM ** -0.5)

    qi = jnp.arange(BLOCK)[:, None]
    kj = jnp.arange(2 * BLOCK)[None, :]
    rel = qi + BLOCK - kj
    band = (rel >= 0) & (rel < WINDOW)
    valid = band[None] & ((jnp.arange(nb)[:, None, None] > 0) | (kj[None] >= BLOCK))
    s = jnp.where(valid[None, :, None, None], s, -jnp.inf)

    sink = sinks.astype(jnp.float32).reshape(N_KV_HEADS, GROUP)[None, None, :, :, None, None]
    m = jnp.maximum(jnp.max(s, -1, keepdims=True), sink)
    p = jnp.exp(s - m)
    p = p / (jnp.sum(p, -1, keepdims=True) + jnp.exp(sink - m))
    o = jnp.einsum('bnhgqk,bnkhd->bnqhgd', p.astype(x.dtype), vb).reshape(Bsz, T, N_Q_HEADS * HEAD_DIM)
    return o @ w_o + b_o


def swiglu_ffn(x, w_gate_up, w_down):
    h = x @ w_gate_up
    gate, up = h[..., :D_FF], h[..., D_FF:]
    return (jax.nn.silu(gate) * up) @ w_down


def setup_inputs(seed: int = 0) -> dict:
    key = jax.random.key(seed)
    ks = iter(jax.random.split(key, 40))
    D, H, N = D_MODEL, RWKV_HEADS, RWKV_HEAD
    nrm = lambda shape, scale: scale * jax.random.normal(next(ks), shape, jnp.float32)
    return {
        "x": nrm((BATCH, SEQ, D), 1.0),
        "norm_g": 1.0 + nrm((DEPTH, 4, D), 0.05),
        "rwkv_x_mix": jax.random.uniform(next(ks), (N_RWKV, 6, D), jnp.float32),
        "rwkv_w_rkv": nrm((N_RWKV, 3, D, D), D ** -0.5),
        "rwkv_w0": jax.random.uniform(next(ks), (N_RWKV, D), jnp.float32, -6.5, -1.5),
        "rwkv_w1": nrm((N_RWKV, D, DECAY_LORA), D ** -0.5),
        "rwkv_w2": nrm((N_RWKV, DECAY_LORA, D), 0.1 * DECAY_LORA ** -0.5),
        "rwkv_a0": nrm((N_RWKV, D), 0.1),
        "rwkv_a1": nrm((N_RWKV, D, ICLR_LORA), D ** -0.5),
        "rwkv_a2": nrm((N_RWKV, ICLR_LORA, D), 0.5 * ICLR_LORA ** -0.5),
        "rwkv_v0": 1.0 + nrm((N_VRES, D), 0.1),
        "rwkv_v1": nrm((N_VRES, D, VRES_LORA), D ** -0.5),
        "rwkv_v2": nrm((N_VRES, VRES_LORA, D), 0.5 * VRES_LORA ** -0.5),
        "rwkv_g1": nrm((N_RWKV, D, GATE_LORA), D ** -0.5),
        "rwkv_g2": nrm((N_RWKV, GATE_LORA, D), GATE_LORA ** -0.5),
        "rwkv_k_k": 0.85 + nrm((N_RWKV, D), 0.05),
        "rwkv_k_a": 1.0 + nrm((N_RWKV, D), 0.05),
        "rwkv_r_k": -0.04 + nrm((N_RWKV, H, N), 0.05),
        "rwkv_lnx_w": 1.0 + nrm((N_RWKV, D), 0.05),
        "rwkv_lnx_b": nrm((N_RWKV, D), 0.02),
        "rwkv_w_o": nrm((N_RWKV, D, D), D ** -0.5),
        "attn_w_qkv": nrm((N_ATTN, D, QKV_DIM), D ** -0.5),
        "attn_b_qkv": nrm((N_ATTN, QKV_DIM), 0.02),
        "attn_sinks": nrm((N_ATTN, N_Q_HEADS), 1.0),
        "attn_w_o": nrm((N_ATTN, N_Q_HEADS * HEAD_DIM, D), (N_Q_HEADS * HEAD_DIM) ** -0.5),
        "attn_b_o": nrm((N_ATTN, D), 0.02),
        "ffn_w_gate_up": nrm((DEPTH, D, 2 * D_FF), D ** -0.5),
        "ffn_w_down": nrm((DEPTH, D_FF, D), D_FF ** -0.5),
    }


def reference(x, norm_g, rwkv_x_mix, rwkv_w_rkv, rwkv_w0, rwkv_w1, rwkv_w2, rwkv_a0, rwkv_a1,
              rwkv_a2, rwkv_v0, rwkv_v1, rwkv_v2, rwkv_g1, rwkv_g2, rwkv_k_k, rwkv_k_a, rwkv_r_k,
              rwkv_lnx_w, rwkv_lnx_b, rwkv_w_o, attn_w_qkv, attn_b_qkv, attn_sinks, attn_w_o,
              attn_b_o, ffn_w_gate_up, ffn_w_down):
    cos, sin = rope_tables(x.shape[1])
    v_first = None
    for i in range(DEPTH):
        j = i // N_MIX
        h = rmsnorm(x, norm_g[i, 0])
        if i % N_MIX == 0:
            vres = None if j == 0 else (rwkv_v0[j - 1], rwkv_v1[j - 1], rwkv_v2[j - 1])
            h, v_first = rwkv7_time_mix(
                h, v_first, rwkv_x_mix[j], rwkv_w_rkv[j], rwkv_w0[j], rwkv_w1[j], rwkv_w2[j],
                rwkv_a0[j], rwkv_a1[j], rwkv_a2[j], rwkv_g1[j], rwkv_g2[j], rwkv_k_k[j],
                rwkv_k_a[j], rwkv_r_k[j], rwkv_lnx_w[j], rwkv_lnx_b[j], rwkv_w_o[j], vres)
        else:
            h = swa_sink_attention(h, attn_w_qkv[j], attn_b_qkv[j], attn_sinks[j],
                                   attn_w_o[j], attn_b_o[j], cos, sin)
        x = x + rmsnorm(h, norm_g[i, 1])
        h = swiglu_ffn(rmsnorm(x, norm_g[i, 2]), ffn_w_gate_up[i], ffn_w_down[i])
        x = x + rmsnorm(h, norm_g[i, 3])
    return x
```

```cpp
#include <hip/hip_runtime.h>
#include <cstdio>
#include <cstdint>

#ifndef MK_N_LAUNCHES
#define MK_N_LAUNCHES 0
#endif
#ifndef USE_PG8
#define USE_PG8 0
#endif

#define LAS __attribute__((address_space(3)))
#define GAS __attribute__((address_space(1)))
typedef unsigned short bf16_t;
typedef short bf16x8 __attribute__((ext_vector_type(8)));
typedef float f32x4 __attribute__((ext_vector_type(4)));
typedef float f32x16 __attribute__((ext_vector_type(16)));
typedef unsigned u32x4 __attribute__((ext_vector_type(4)));
typedef unsigned u32x2 __attribute__((ext_vector_type(2)));

constexpr int BATCH = 8, SEQ = 2048, D = 1024, M = BATCH * SEQ, DFF = 2816, NH = 16, HD = 64, NKV = 4;
constexpr int NBIG = 3584;
constexpr int KBIG = 2048;
constexpr int NL2 = 4096, KL2 = 256, LDL1 = 512;
constexpr int NQKV = 1536;
constexpr float RMS_EPS = 1e-6f, GN_EPS = 64e-5f;
constexpr float LOG2E = 1.4426950408889634f;
constexpr float QSCALE = 0.125f * LOG2E;

constexpr size_t MiB = 1u << 20;
constexpr size_t WS_CTL = 0, CTL_ZERO_BYTES = 1 * MiB;
constexpr size_t WS_ROPE = 1 * MiB;
constexpr size_t WS_BIAS4 = 1 * MiB + 512 * 1024;
constexpr size_t WS_WBIG = 2 * MiB, WS_WL2 = 16 * MiB, WS_WOR = 18 * MiB;
constexpr size_t WS_WQKV = 20 * MiB, WS_WOA = 23 * MiB;
constexpr size_t WS_WGU_A = 25 * MiB, WS_WD_A = 36 * MiB;
constexpr size_t WS_WGU_B = 42 * MiB, WS_WD_B = 53 * MiB;
constexpr size_t WS_XCH = 59 * MiB;
constexpr size_t WS_XN = 64 * MiB;
constexpr size_t WS_R = 97 * MiB, WS_K = 129 * MiB, WS_V = 161 * MiB, WS_VF = 193 * MiB, WS_AG = 225 * MiB, WS_GG = 257 * MiB, WS_VG = 289 * MiB, WS_L1 = 321 * MiB, WS_END = 337 * MiB;
constexpr size_t WS_LW = WS_XN, WS_YG = WS_R, WS_XN2 = WS_K, WS_TMP = WS_V, WS_H = WS_AG;
constexpr size_t WS_Q = WS_R, WS_KA = WS_K, WS_VA = WS_K + 8 * MiB, WS_O = WS_AG;
static_assert(WS_WBIG + (size_t)NBIG * KBIG * 2 <= WS_WL2 && WS_WL2 + (size_t)NL2 * KL2 * 2 <= WS_WOR && WS_WOR + (size_t)D * D * 2 <= WS_WQKV, "ws map 1");
static_assert(WS_WQKV + (size_t)NQKV * D * 2 <= WS_WOA && WS_WOA + (size_t)D * D * 2 <= WS_WGU_A, "ws map 2");
static_assert(WS_WGU_A + (size_t)2 * DFF * D * 2 <= WS_WD_A && WS_WD_A + (size_t)D * DFF * 2 <= WS_WGU_B && WS_WGU_B + (size_t)2 * DFF * D * 2 <= WS_WD_B && WS_WD_B + (size_t)D * DFF * 2 <= WS_XCH, "ws map 3");
static_assert(WS_XN + (size_t)(BATCH * (SEQ + 1)) * D * 2 <= WS_R && WS_H + (size_t)M * DFF * 2 <= WS_L1, "ws map 4");

constexpr int CW_TMO = 0, CW_CODE = 1, CW_BAR = 4096;

#define LDS_WAIT() asm volatile("s_waitcnt lgkmcnt(0)" ::: "memory")
#define VM_WAIT() asm volatile("s_waitcnt vmcnt(0)" ::: "memory")
#define RLX_AGENT __ATOMIC_RELAXED, __HIP_MEMORY_SCOPE_AGENT
__device__ __forceinline__ unsigned f2bf(float f) { unsigned u = __builtin_bit_cast(unsigned, f); return (u + 0x7fffu + ((u >> 16) & 1u)) >> 16; }
__device__ __forceinline__ unsigned pk2(float lo, float hi) { return f2bf(lo) | (f2bf(hi) << 16); }
__device__ __forceinline__ float bf2f(unsigned short b) { return __builtin_bit_cast(float, (unsigned)b << 16); }
__device__ __forceinline__ float bflo(unsigned w) { return __builtin_bit_cast(float, w << 16); }
__device__ __forceinline__ float bfhi(unsigned w) { return __builtin_bit_cast(float, w & 0xffff0000u); }
__device__ __forceinline__ float sigmoidf_(float x) { return 1.0f / (1.0f + __expf(-x)); }
__device__ __forceinline__ float tanh_fast(float x) { const float e = __expf(2.0f * fminf(fmaxf(x, -15.f), 15.f)); return (e - 1.0f) / (e + 1.0f); }
__device__ __forceinline__ float logdecay(float u) { const float z = -u; const float sp = fmaxf(z, 0.f) + __logf(1.0f + __expf(-fabsf(z))); return -__expf(-sp - 0.5f); }
__device__ __forceinline__ float wave_sum(float v) {
#pragma unroll
    for (int o = 1; o < 64; o <<= 1) v += __shfl_xor(v, o);
    return v;
}
__device__ __forceinline__ float sum8(float v) { v += __shfl_xor(v, 1); v += __shfl_xor(v, 2); v += __shfl_xor(v, 4); return v; }
__device__ __forceinline__ void unpack8(const u32x4 w, float (&o)[8]) { o[0] = bflo(w.x); o[1] = bfhi(w.x); o[2] = bflo(w.y); o[3] = bfhi(w.y); o[4] = bflo(w.z); o[5] = bfhi(w.z); o[6] = bflo(w.w); o[7] = bfhi(w.w); }

namespace pg8 {
constexpr int BM = 256, BK = 64, HALF = 128, HTB = HALF * BK * 2, STAGE_BYTES = 8 * HTB, NXCD = 8, WGM = 8;
__host__ __device__ __forceinline__ int lds_byte(int r, int c) { const int st = (r >> 4) * 2 + (c >> 5), rr = r & 15, cc = c & 31, ob = rr * 64 + cc * 2; return st * 1024 + (ob ^ (((ob >> 9) & 1) << 5)); }
__host__ __device__ __forceinline__ void stage_rc(int b, int& R, int& C) { const int st = b / 1024, sb = b % 1024, swz = sb ^ (((sb >> 9) & 1) << 5); R = (st >> 1) * 16 + swz / 64; C = (st & 1) * 32 + (swz % 64) / 2; }
__host__ __device__ __forceinline__ int perm32(int rho) { const int n = rho >> 4, i = rho & 15; return 8 * (i >> 2) + 4 * n + (i & 3); }

struct Unit { int pm, pn; };
struct Gemm {
    const bf16_t* A; const bf16_t* Bt; int M, N, K, lda, ldb;
    int a_mode;
    int a_coltile, a_coloff;
    __device__ __forceinline__ const char* a_ptr(int pm, int pn) const {
        const size_t row = (size_t)pm * 256 + (a_mode == 0 ? 0 : (pm >> 3) + (a_mode == 1 ? 1 : 0));
        return (const char*)(A + row * lda + (pn >= a_coltile ? a_coloff : 0));
    }
    __device__ __forceinline__ const char* b_ptr(int pn) const { return (const char*)(Bt + (size_t)pn * 256 * ldb); }
};
struct StaticOrder {
    int nM, nN, nwg, G, c;
    __host__ __device__ void init(int M_, int N_, int G_, int c_) { nM = M_ / BM; nN = N_ / BM; nwg = nM * nN; G = G_; c = c_; }
    __host__ __device__ bool next(int i, Unit& u) const {
        const long L = (long)i * G + c; if (L >= nwg) return false;
        int wgid = (int)L; { const int q = nwg / NXCD, r = nwg % NXCD, xcd = wgid % NXCD, off = wgid / NXCD; wgid = (xcd < r ? xcd * (q + 1) : r * (q + 1) + (xcd - r) * q) + off; }
        const int nig = WGM * nN, gid = wgid / nig, fm = gid * WGM, gsz = (nM - fm) < WGM ? (nM - fm) : WGM;
        u.pm = fm + ((wgid % nig) % gsz); u.pn = (wgid % nig) / gsz; return true;
    }
};

template <class Epi>
__device__ __forceinline__ void gemm_simple(const Gemm g, int G, int c, const Epi& E, int tid) {
    const int wid = __builtin_amdgcn_readfirstlane(tid >> 6), lane = tid & 63, wr = wid >> 2, wc = wid & 3, fr = lane & 15, fq = lane >> 4;
    StaticOrder S; S.init(g.M, g.N, G, c);
    Unit u;
    for (int i = 0; S.next(i, u); ++i) {
        f32x4 acc[2][2][4][2];
#pragma unroll
        for (int a = 0; a < 2; ++a)
#pragma unroll
            for (int b = 0; b < 2; ++b)
#pragma unroll
                for (int m = 0; m < 4; ++m)
#pragma unroll
                    for (int n = 0; n < 2; ++n) acc[a][b][m][n] = (f32x4){0.f, 0.f, 0.f, 0.f};
        const char* Ab = g.a_ptr(u.pm, u.pn);
        const char* Bb = g.b_ptr(u.pn);
        const unsigned aoff = (unsigned)((wr * 64 + fr) * g.lda + fq * 8) * 2u;
        unsigned boff[2];
#pragma unroll
        for (int n = 0; n < 2; ++n) { const int rho = 16 * n + fr; boff[n] = (unsigned)((wc * 32 + (Epi::PERM ? perm32(rho) : rho)) * g.ldb + fq * 8) * 2u; }
        const unsigned a16 = (unsigned)(16 * g.lda) * 2u, a128 = 8u * a16, b128 = (unsigned)(128 * g.ldb) * 2u;
#pragma unroll 1
        for (int k0 = 0; k0 < g.K; k0 += 32) {
            bf16x8 b[2][2];
#pragma unroll
            for (int bj = 0; bj < 2; ++bj)
#pragma unroll
                for (int n = 0; n < 2; ++n) b[bj][n] = *(const bf16x8*)(Bb + (boff[n] + bj * b128 + (unsigned)k0 * 2u));
#pragma unroll
            for (int ai = 0; ai < 2; ++ai) {
                bf16x8 a[4];
#pragma unroll
                for (int m = 0; m < 4; ++m) a[m] = *(const bf16x8*)(Ab + (aoff + ai * a128 + m * a16 + (unsigned)k0 * 2u));
#pragma unroll
                for (int bj = 0; bj < 2; ++bj)
#pragma unroll
                    for (int m = 0; m < 4; ++m)
#pragma unroll
                        for (int n = 0; n < 2; ++n) acc[ai][bj][m][n] = __builtin_amdgcn_mfma_f32_16x16x32_bf16(b[bj][n], a[m], acc[ai][bj][m][n], 0, 0, 0);
            }
        }
        asm volatile("" ::: "memory");
        E(acc, u, wr, wc, fr, fq);
    }
}
}

namespace epi {
using pg8::Unit; using pg8::BM; using pg8::HALF;
__device__ __forceinline__ u32x4 pack8(const f32x4 v0, const f32x4 v1) { u32x4 w; w.x = pk2(v0[0], v0[1]); w.y = pk2(v0[2], v0[3]); w.z = pk2(v1[0], v1[1]); w.w = pk2(v1[2], v1[3]); return w; }

struct Bf16Out {
    static constexpr bool PERM = true, AFTER_DRAIN = false;
    bf16_t* O; int ldc; const float* bias;
    __device__ __forceinline__ void operator()(const f32x4 (&acc)[2][2][4][2], const Unit& u, int wr, int wc, int fr, int fq) const {
        const int row0 = u.pm * BM + wr * 64 + fr, col0 = u.pn * BM + wc * 32 + 8 * fq;
#pragma unroll
        for (int bj = 0; bj < 2; ++bj) {
            f32x4 b0 = (f32x4){0.f, 0.f, 0.f, 0.f}, b1 = b0;
            if (bias) { b0 = *(const f32x4*)(bias + col0 + bj * HALF); b1 = *(const f32x4*)(bias + col0 + bj * HALF + 4); }
#pragma unroll
            for (int ai = 0; ai < 2; ++ai)
#pragma unroll
                for (int m = 0; m < 4; ++m) {
                    bf16_t* p = O + (size_t)(row0 + ai * HALF + m * 16) * ldc + col0 + bj * HALF;
                    *(u32x4*)p = pack8(acc[ai][bj][m][0] + b0, acc[ai][bj][m][1] + b1);
                }
        }
    }
};

struct BigOut {
    static constexpr bool PERM = true, AFTER_DRAIN = false;
    unsigned char* ws; size_t v_off;
    __device__ __forceinline__ void operator()(const f32x4 (&acc)[2][2][4][2], const Unit& u, int wr, int wc, int fr, int fq) const {
        const int row0 = u.pm * BM + wr * 64 + fr;
        const int grp = u.pn >> 2;
        size_t boff = WS_R + (size_t)grp * (32 * MiB); if (grp == 2) boff = v_off; if (grp == 3) boff = WS_L1;
        bf16_t* base = (bf16_t*)(ws + boff);
        const int ldc = (grp == 3) ? LDL1 : D, colt = (grp == 3) ? (u.pn - 12) * BM : (u.pn & 3) * BM;
        int act0 = 0, act1 = 0;
        if (u.pn == 12) { act0 = (wc < 2) ? 1 : 0; act1 = 2; }
        const int col0 = colt + wc * 32 + 8 * fq;
#pragma unroll
        for (int bj = 0; bj < 2; ++bj) {
            const int act = bj ? act1 : act0;
#pragma unroll
            for (int ai = 0; ai < 2; ++ai)
#pragma unroll
                for (int m = 0; m < 4; ++m) {
                    f32x4 v0 = acc[ai][bj][m][0], v1 = acc[ai][bj][m][1];
                    if (act == 1) {
#pragma unroll
                        for (int j = 0; j < 4; ++j) { v0[j] = tanh_fast(v0[j]); v1[j] = tanh_fast(v1[j]); }
                    } else if (act == 2) {
#pragma unroll
                        for (int j = 0; j < 4; ++j) { v0[j] = sigmoidf_(v0[j]); v1[j] = sigmoidf_(v1[j]); }
                    }
                    *(u32x4*)(base + (size_t)(row0 + ai * HALF + m * 16) * ldc + col0 + bj * HALF) = pack8(v0, v1);
                }
        }
    }
};

struct L2Out {
    static constexpr bool PERM = true, AFTER_DRAIN = false;
    unsigned char* ws; const float* bias4;
    __device__ __forceinline__ void operator()(const f32x4 (&acc)[2][2][4][2], const Unit& u, int wr, int wc, int fr, int fq) const {
        const int row0 = u.pm * BM + wr * 64 + fr, grp = u.pn >> 2, col0 = (u.pn & 3) * BM + wc * 32 + 8 * fq;
        bf16_t* base = (bf16_t*)(ws + (grp == 0 ? WS_LW : WS_AG + (size_t)(grp - 1) * (32 * MiB)));
        const float* bias = bias4 + grp * D;
#pragma unroll
        for (int bj = 0; bj < 2; ++bj) {
            const f32x4 b0 = *(const f32x4*)(bias + col0 + bj * HALF), b1 = *(const f32x4*)(bias + col0 + bj * HALF + 4);
#pragma unroll
            for (int ai = 0; ai < 2; ++ai)
#pragma unroll
                for (int m = 0; m < 4; ++m) {
                    f32x4 v0_ = acc[ai][bj][m][0] + b0, v1_ = acc[ai][bj][m][1] + b1;
                    if (grp == 0) {
#pragma unroll
                        for (int j = 0; j < 4; ++j) { v0_[j] = logdecay(v0_[j]); v1_[j] = logdecay(v1_[j]); }
                    } else if (grp != 2) {
#pragma unroll
                        for (int j = 0; j < 4; ++j) { v0_[j] = sigmoidf_(v0_[j]); v1_[j] = sigmoidf_(v1_[j]); }
                    }
                    *(u32x4*)(base + (size_t)(row0 + ai * HALF + m * 16) * D + col0 + bj * HALF) = pack8(v0_, v1_);
                }
        }
    }
};

struct QkvOut {
    static constexpr bool PERM = true, AFTER_DRAIN = false;
    unsigned char* ws; const float* bias; const float* rope;
    __device__ __forceinline__ void operator()(const f32x4 (&acc)[2][2][4][2], const Unit& u, int wr, int wc, int fr, int fq) const {
        const int row0 = u.pm * BM + wr * 64 + fr;
        const bool isq = u.pn < 4;
        bf16_t* base = (bf16_t*)(ws + (isq ? WS_Q : WS_KA + (size_t)(u.pn - 4) * (8 * MiB)));
        const int ldc = isq ? D : 256, colt = isq ? u.pn * BM : 0; const float sc = isq ? QSCALE : 1.f;
        const bool rot = (u.pn < 5) && ((wc & 1) == 0) && (fq < 2);
#pragma unroll
        for (int bj = 0; bj < 2; ++bj) {
            const int cl = bj * HALF + wc * 32 + 8 * fq;
            const int scol = u.pn * BM + cl;
            float bv[8];
#pragma unroll
            for (int i = 0; i < 8; ++i) {
                const int dp = (scol + i) & 63; int d = dp;
                if (u.pn < 5 && dp < 16) d = (dp >> 1) + 8 * (dp & 1);
                bv[i] = bias[((scol + i) & ~63) + d];
            }
#pragma unroll
            for (int ai = 0; ai < 2; ++ai)
#pragma unroll
                for (int m = 0; m < 4; ++m) {
                    const int row = row0 + ai * HALF + m * 16;
                    float v[8];
#pragma unroll
                    for (int i = 0; i < 4; ++i) { v[i] = acc[ai][bj][m][0][i] + bv[i]; v[4 + i] = acc[ai][bj][m][1][i] + bv[4 + i]; }
                    if (rot) {
                        const int pos = row & (SEQ - 1);
                        const f32x4 cs = *(const f32x4*)(rope + pos * 8 + 4 * fq), sn = *(const f32x4*)(rope + SEQ * 8 + pos * 8 + 4 * fq);
#pragma unroll
                        for (int i = 0; i < 4; ++i) { const float x1 = v[2 * i], x2 = v[2 * i + 1]; v[2 * i] = x1 * cs[i] - x2 * sn[i]; v[2 * i + 1] = x2 * cs[i] + x1 * sn[i]; }
                    }
                    u32x4 w; w.x = pk2(v[0] * sc, v[1] * sc); w.y = pk2(v[2] * sc, v[3] * sc); w.z = pk2(v[4] * sc, v[5] * sc); w.w = pk2(v[6] * sc, v[7] * sc);
                    *(u32x4*)(base + (size_t)row * ldc + colt + cl) = w;
                }
        }
    }
};

struct SwigluOut {
    static constexpr bool PERM = true, AFTER_DRAIN = false;
    bf16_t* H;
    __device__ __forceinline__ void operator()(const f32x4 (&acc)[2][2][4][2], const Unit& u, int wr, int wc, int fr, int fq) const {
        const int row0 = u.pm * BM + wr * 64 + fr, col0 = u.pn * HALF + wc * 32 + 8 * fq;
#pragma unroll
        for (int ai = 0; ai < 2; ++ai)
#pragma unroll
            for (int m = 0; m < 4; ++m) {
                f32x4 o0, o1;
#pragma unroll
                for (int j = 0; j < 4; ++j) {
                    const float g0 = acc[ai][0][m][0][j], g1 = acc[ai][0][m][1][j];
                    o0[j] = g0 * sigmoidf_(g0) * acc[ai][1][m][0][j]; o1[j] = g1 * sigmoidf_(g1) * acc[ai][1][m][1][j];
                }
                *(u32x4*)(H + (size_t)(row0 + ai * HALF + m * 16) * DFF + col0) = pack8(o0, o1);
            }
    }
};
}

#define XB_TMO      128
#define XB_XCNT(j)  (256  + 64 * (j))
#define XB_XSUB(j)  (1280 + 64 * (j))
#define XB_XGEN(j)  (2304 + 64 * (j))
#define XB_TOP      3328
#define XB_TOPGEN   3392
#define XCD_BAR_WORDS 3456
#define XB_SPIN_CAP (1u << 22)
__device__ __forceinline__ unsigned xb_ld(unsigned* p)              { return __hip_atomic_load(p, __ATOMIC_RELAXED, __HIP_MEMORY_SCOPE_AGENT); }
__device__ __forceinline__ unsigned xb_add(unsigned* p, unsigned v) { return __hip_atomic_fetch_add(p, v, __ATOMIC_RELAXED, __HIP_MEMORY_SCOPE_AGENT); }
__device__ __forceinline__ unsigned xb_xcc_id() { return (unsigned)__builtin_amdgcn_s_getreg((3 << 11) | 20) & 0xFu; }
#define XB_SPIN(cond, bar) do { unsigned _sp = 0; while (cond) { __builtin_amdgcn_s_sleep(1); \
    if ((++_sp & 255u) == 0u) { if (xb_ld(&(bar)[XB_TMO])) break; if (_sp > XB_SPIN_CAP) { atomicAdd(&(bar)[XB_TMO], 1u); break; } } } } while (0)
struct XcdBarrier { unsigned* bar; unsigned x; volatile LAS unsigned* st; };
__device__ __forceinline__ XcdBarrier xcd_barrier_post(unsigned* bar, volatile LAS unsigned* st) {
    XcdBarrier b; b.bar = bar; b.x = xb_xcc_id(); b.st = st;
    if (threadIdx.x == 0) (void)xb_add(&bar[XB_XCNT(b.x)], 1u);
    return b;
}
__device__ __forceinline__ void xcd_barrier_complete(unsigned* bar, unsigned x, unsigned& nloc, unsigned& nx) {
    const unsigned G = gridDim.x * gridDim.y * gridDim.z;
    unsigned sum, cnt, mine, sp = 0u;
    for (;;) {
        sum = 0u; cnt = 0u; mine = 0u;
#pragma unroll
        for (unsigned j = 0; j < 16; ++j) { const unsigned c = xb_ld(&bar[XB_XCNT(j)]); sum += c; cnt += (c > 0u) ? 1u : 0u; mine = (j == x) ? c : mine; }
        if (sum == G) break;
        __builtin_amdgcn_s_sleep(1);
        if ((++sp & 255u) == 0u) { if (xb_ld(&bar[XB_TMO])) break; if (sp > XB_SPIN_CAP) { atomicAdd(&bar[XB_TMO], 1u); break; } }
    }
    nloc = mine > 0u ? mine : 1u; nx = cnt > 0u ? cnt : 1u;
}
__device__ __forceinline__ void xcd_barrier(const XcdBarrier& b) {
    asm volatile("s_waitcnt vmcnt(0)" ::: "memory");
    __syncthreads();
    if (threadIdx.x == 0) {
        unsigned* bar = b.bar;
        __builtin_amdgcn_s_waitcnt(0);
        unsigned nloc = b.st[0], nx = b.st[1];
        if (nloc == 0u) { xcd_barrier_complete(bar, b.x, nloc, nx); b.st[0] = nloc; b.st[1] = nx; }
        const unsigned old = xb_add(&bar[XB_XSUB(b.x)], 1u);
        const unsigned gen = old / nloc;
        if (old + 1u == (gen + 1u) * nloc) {
            __builtin_amdgcn_fence(__ATOMIC_RELEASE, "agent");
            asm volatile("s_waitcnt vmcnt(0)" ::: "memory");
            const unsigned og = xb_add(&bar[XB_TOP], 1u);
            const unsigned tg = og / nx;
            if (og + 1u == (tg + 1u) * nx) xb_add(&bar[XB_TOPGEN], 1u);
            else XB_SPIN(xb_ld(&bar[XB_TOPGEN]) == tg, bar);
            __builtin_amdgcn_fence(__ATOMIC_ACQUIRE, "agent");
            xb_add(&bar[XB_XGEN(b.x)], 1u);
            asm volatile("s_waitcnt vmcnt(0)" ::: "memory");
        } else {
            XB_SPIN(xb_ld(&bar[XB_XGEN(b.x)]) == gen, bar);
            __builtin_amdgcn_fence(__ATOMIC_ACQUIRE, "agent");
            asm volatile("s_waitcnt vmcnt(0)" ::: "memory");
        }
    }
    __syncthreads();
}

constexpr int RING_OFF = 0, RING_BYTES = 131072;
constexpr int LDSCTL_OFF = RING_BYTES, MISC_OFF = LDSCTL_OFF + 320;
constexpr int LDS_BYTES = 147456;
constexpr int NWAVES = 8;

struct Args { const float* in[28]; float* out; unsigned char* ws; int ph_lo, ph_hi; };
enum { I_X = 0, I_NORMG, I_XMIX, I_WRKV, I_W0, I_W1, I_W2, I_A0, I_A1, I_A2, I_V0, I_V1, I_V2, I_G1, I_G2, I_KK, I_KA, I_RK, I_LNW, I_LNB, I_WOR,
       I_WQKV, I_BQKV, I_SINK, I_WOA, I_BOA, I_WGU, I_WD };

template <class F>
__device__ __forceinline__ void cvt_matrix(bf16_t* WT, int N, int K, const F& f, LAS float* scr, int gw, int NGW, int lane) {
    const int nblk = N / 32, nitems = nblk * (K / 64);
    for (int it = gw; it < nitems; it += NGW) {
        const int kb = it / nblk, nb = it % nblk, k0 = 64 * kb, n0 = 32 * nb;
#pragma unroll 8
        for (int i = 0; i < 32; ++i) { const int kk = 2 * i + (lane >> 5); scr[kk * 33 + (lane & 31)] = f(n0 + (lane & 31), k0 + kk); }
        LDS_WAIT(); asm volatile("" ::: "memory");
        const int c = lane & 7;
#pragma unroll
        for (int j = 0; j < 4; ++j) { const int n = (lane >> 3) + 8 * j; const LAS float* s = scr + (8 * c) * 33 + n;
            u32x4 o; o.x = pk2(s[0 * 33], s[1 * 33]); o.y = pk2(s[2 * 33], s[3 * 33]); o.z = pk2(s[4 * 33], s[5 * 33]); o.w = pk2(s[6 * 33], s[7 * 33]);
            *(u32x4*)(WT + (size_t)(n0 + n) * K + k0 + 8 * c) = o; }
        LDS_WAIT(); asm volatile("" ::: "memory");
    }
}
struct FBig {
    const float *wrkv, *w1, *a1, *g1, *v1, *mix; int has_v;
    __device__ __forceinline__ float operator()(int n, int k) const {
        const int kk = k & 1023; float w; int mi;
        if (n < 3072) { mi = n >> 10; w = wrkv[((size_t)mi * D + kk) * D + (n & 1023)]; }
        else if (n < 3136) { mi = 3; w = w1[kk * 64 + (n - 3072)]; }
        else if (n < 3200) { mi = 4; w = a1[kk * 64 + (n - 3136)]; }
        else if (n < 3328) { mi = 5; w = g1[kk * 128 + (n - 3200)]; }
        else if (n < 3360 && has_v) { mi = 2; w = v1[kk * 32 + (n - 3328)]; }
        else return 0.f;
        const float mx = mix[mi * D + kk];
        return w * (k < 1024 ? mx : 1.0f - mx);
    }
};
struct FL2 {
    const float *w2, *a2, *g2, *v2; int has_v;
    __device__ __forceinline__ float operator()(int n, int k) const {
        const int grp = n >> 10, c = n & 1023;
        if (grp == 0) return k < 64 ? w2[k * D + c] : 0.f;
        if (grp == 1) return (k >= 64 && k < 128) ? a2[(k - 64) * D + c] : 0.f;
        if (grp == 2) return k >= 128 ? g2[(k - 128) * D + c] : 0.f;
        return (k < 32 && has_v) ? v2[k * D + c] : 0.f;
    }
};
struct FPlain { const float* W; int N;
    __device__ __forceinline__ float operator()(int n, int k) const { return W[(size_t)k * N + n]; } };
struct FQkv { const float* W;
    __device__ __forceinline__ float operator()(int n, int k) const { int sn = n; if (n < 1280) { const int dp = n & 63; if (dp < 16) sn = (n & ~63) + (dp >> 1) + 8 * (dp & 1); } return W[(size_t)k * NQKV + sn]; } };
struct FGu { const float* W;
    __device__ __forceinline__ float operator()(int n, int k) const { const int t = n >> 8, r = n & 255; const int sn = (r < 128) ? t * 128 + r : DFF + t * 128 + (r - 128); return W[(size_t)k * (2 * DFF) + sn]; } };

__device__ __forceinline__ void cvt_rwkv(const Args& a, int j, unsigned char* ws, LAS float* scr, int gw, int NGW, int lane) {
    FBig fb{a.in[I_WRKV] + (size_t)j * 3 * D * D, a.in[I_W1] + (size_t)j * D * 64, a.in[I_A1] + (size_t)j * D * 64, a.in[I_G1] + (size_t)j * D * 128, a.in[I_V1], a.in[I_XMIX] + (size_t)j * 6 * D, j > 0 ? 1 : 0};
    cvt_matrix((bf16_t*)(ws + WS_WBIG), NBIG, KBIG, fb, scr, gw, NGW, lane);
    FL2 f2{a.in[I_W2] + (size_t)j * 64 * D, a.in[I_A2] + (size_t)j * 64 * D, a.in[I_G2] + (size_t)j * 128 * D, a.in[I_V2], j > 0 ? 1 : 0};
    cvt_matrix((bf16_t*)(ws + WS_WL2), NL2, KL2, f2, scr, gw, NGW, lane);
    FPlain fo{a.in[I_WOR] + (size_t)j * D * D, D};
    cvt_matrix((bf16_t*)(ws + WS_WOR), D, D, fo, scr, gw, NGW, lane);
    for (int e = gw * 64 + lane; e < 4 * D; e += NGW * 64) { const int grp = e >> 10, c = e & 1023; float v = 0.f;
        if (grp == 0) v = a.in[I_W0][j * D + c]; else if (grp == 1) v = a.in[I_A0][j * D + c]; else if (grp == 3) v = a.in[I_V0][c];
        ((float*)(ws + WS_BIAS4))[e] = v; }
}
__device__ __forceinline__ void cvt_attn(const Args& a, int j, unsigned char* ws, LAS float* scr, int gw, int NGW, int lane) {
    FQkv fq{a.in[I_WQKV] + (size_t)j * D * NQKV};
    cvt_matrix((bf16_t*)(ws + WS_WQKV), NQKV, D, fq, scr, gw, NGW, lane);
    FPlain fo{a.in[I_WOA] + (size_t)j * D * D, D};
    cvt_matrix((bf16_t*)(ws + WS_WOA), D, D, fo, scr, gw, NGW, lane);
}
__device__ __forceinline__ void cvt_ffn(const Args& a, int i, unsigned char* ws, LAS float* scr, int gw, int NGW, int lane) {
    const size_t ogu = (i & 1) ? WS_WGU_B : WS_WGU_A, od = (i & 1) ? WS_WD_B : WS_WD_A;
    FGu fg{a.in[I_WGU] + (size_t)i * D * 2 * DFF};
    cvt_matrix((bf16_t*)(ws + ogu), 2 * DFF, D, fg, scr, gw, NGW, lane);
    FPlain fd{a.in[I_WD] + (size_t)i * DFF * D, D};
    cvt_matrix((bf16_t*)(ws + od), D, DFF, fd, scr, gw, NGW, lane);
}

__device__ __forceinline__ size_t xn_row(int m) { return (size_t)m + (m >> 11) + 1; }
__device__ __forceinline__ void norm_rows(const float* x, const float* g, bf16_t* xn, int gw, int NGW, int lane) {
    f32x4 gv[4];
#pragma unroll
    for (int j = 0; j < 4; ++j) gv[j] = *((const f32x4*)g + lane + 64 * j);
    for (int m = gw; m < M; m += NGW) {
        const f32x4* xr = (const f32x4*)(x + (size_t)m * D) + lane;
        f32x4 v[4]; float s = 0.f;
#pragma unroll
        for (int j = 0; j < 4; ++j) { v[j] = xr[64 * j]; s += (v[j][0] * v[j][0] + v[j][1] * v[j][1]) + (v[j][2] * v[j][2] + v[j][3] * v[j][3]); }
        const float rstd = 1.0f / sqrtf(wave_sum(s) * (1.f / D) + RMS_EPS);
        u32x2* o = (u32x2*)(xn + xn_row(m) * D) + lane;
#pragma unroll
        for (int j = 0; j < 4; ++j) { u32x2 w; w.x = pk2(v[j][0] * rstd * gv[j][0], v[j][1] * rstd * gv[j][1]); w.y = pk2(v[j][2] * rstd * gv[j][2], v[j][3] * rstd * gv[j][3]); o[64 * j] = w; }
    }
}
__device__ __forceinline__ void resnorm_rows(const bf16_t* tmp, const float* xin, float* xout, const float* ga, const float* gb, bf16_t* xn, bool guard, int gw, int NGW, int lane) {
    for (int m = gw; m < M; m += NGW) {
        const u32x2* tr = (const u32x2*)(tmp + (size_t)m * D) + lane;
        const f32x4* xr = (const f32x4*)(xin + (size_t)m * D) + lane;
        f32x4 t[4], v[4]; float s = 0.f;
#pragma unroll
        for (int j = 0; j < 4; ++j) { const u32x2 w = tr[64 * j]; t[j] = (f32x4){bflo(w.x), bfhi(w.x), bflo(w.y), bfhi(w.y)}; v[j] = xr[64 * j];
            s += (t[j][0] * t[j][0] + t[j][1] * t[j][1]) + (t[j][2] * t[j][2] + t[j][3] * t[j][3]); }
        const float r1 = 1.0f / sqrtf(wave_sum(s) * (1.f / D) + RMS_EPS);
        float s2 = 0.f;
        f32x4* xo = (f32x4*)(xout + (size_t)m * D) + lane;
#pragma unroll
        for (int j = 0; j < 4; ++j) { const f32x4 gv = *((const f32x4*)ga + lane + 64 * j); v[j] = v[j] + t[j] * r1 * gv; xo[64 * j] = v[j];
            s2 += (v[j][0] * v[j][0] + v[j][1] * v[j][1]) + (v[j][2] * v[j][2] + v[j][3] * v[j][3]); }
        if (xn) {
            const float r2 = 1.0f / sqrtf(wave_sum(s2) * (1.f / D) + RMS_EPS);
            u32x2* o = (u32x2*)(xn + (guard ? xn_row(m) : (size_t)m) * D) + lane;
#pragma unroll
            for (int j = 0; j < 4; ++j) { const f32x4 gv = *((const f32x4*)gb + lane + 64 * j); u32x2 w; w.x = pk2(v[j][0] * r2 * gv[0], v[j][1] * r2 * gv[1]); w.y = pk2(v[j][2] * r2 * gv[2], v[j][3] * r2 * gv[3]); o[64 * j] = w; }
        }
    }
}

struct ScanArgs { const bf16_t *R, *K, *V, *VF, *LW, *AG, *GG, *VG; bf16_t* YG; const float *k_k, *k_a, *r_k, *lnw, *lnb; int layer2; };
__device__ __forceinline__ void scan_v1(const ScanArgs& s, LAS unsigned char* lds, int unit0, int ustride) {
    LAS float* Wd = (LAS float*)lds;
    LAS float* Aa = Wd + 4096;
    LAS float* Bb = Aa + 4096;
    LAS float* Kk = Bb + 4096;
    LAS float* Rr = Kk + 4096;
    LAS float* Vv = Rr + 4096;
    LAS float* Yy = Vv + 4096;
    LAS float* Bn = Yy + 4096;
    int tid = threadIdx.x; asm volatile("" : "+v"(tid));
    const int q8 = tid & 7, hi6 = tid >> 3;
    for (int unit = unit0; unit < BATCH * NH; unit += ustride) {
        const int b = unit >> 4, h = unit & 15, col = h * 64 + 8 * q8;
        float kkw[8], kaw[8], rkw[8], lw_[8], lb_[8];
#pragma unroll
        for (int i = 0; i < 8; ++i) { kkw[i] = s.k_k[col + i]; kaw[i] = s.k_a[col + i]; rkw[i] = s.r_k[col + i]; lw_[i] = s.lnw[col + i]; lb_[i] = s.lnb[col + i]; }
        float S[8];
#pragma unroll
        for (int i = 0; i < 8; ++i) S[i] = 0.f;
        for (int c = 0; c < SEQ / 64; ++c) {
            const size_t off = ((size_t)b * SEQ + c * 64 + hi6) * D + col;
            float gate[8];
            {
                float r[8], k[8], v[8], lw[8], ag[8];
                unpack8(*(const u32x4*)(s.R + off), r); unpack8(*(const u32x4*)(s.K + off), k); unpack8(*(const u32x4*)(s.V + off), v);
                unpack8(*(const u32x4*)(s.LW + off), lw); unpack8(*(const u32x4*)(s.AG + off), ag); unpack8(*(const u32x4*)(s.GG + off), gate);
                if (s.layer2) { float vf[8], vg[8]; unpack8(*(const u32x4*)(s.VF + off), vf); unpack8(*(const u32x4*)(s.VG + off), vg);
#pragma unroll
                    for (int i = 0; i < 8; ++i) v[i] = v[i] + (vf[i] - v[i]) * vg[i]; }
                float kk[8], ss = 0.f, bon = 0.f;
#pragma unroll
                for (int i = 0; i < 8; ++i) { kk[i] = k[i] * kkw[i]; ss += kk[i] * kk[i]; }
                ss = sum8(ss);
                const float inv = 1.0f / fmaxf(sqrtf(ss), 1e-12f);
#pragma unroll
                for (int i = 0; i < 8; ++i) {
                    kk[i] *= inv;
                    const float kp = k[i] * (1.0f + (ag[i] - 1.0f) * kaw[i]);
                    bon += r[i] * kp * rkw[i];
                    const int li = hi6 * 64 + 8 * q8 + i;
                    Wd[li] = __expf(lw[i]); Aa[li] = -kk[i]; Bb[li] = kk[i] * ag[i]; Kk[li] = kp; Rr[li] = r[i]; Vv[li] = v[i];
                }
                bon = sum8(bon);
                if (q8 == 0) Bn[hi6] = bon;
            }
            __syncthreads();
            for (int t = 0; t < 64; ++t) {
                const int li = t * 64 + 8 * q8;
                const f32x4 w0 = *(const LAS f32x4*)(Wd + li), w1 = *(const LAS f32x4*)(Wd + li + 4), a0 = *(const LAS f32x4*)(Aa + li), a1 = *(const LAS f32x4*)(Aa + li + 4);
                const f32x4 b0 = *(const LAS f32x4*)(Bb + li), b1 = *(const LAS f32x4*)(Bb + li + 4), k0 = *(const LAS f32x4*)(Kk + li), k1 = *(const LAS f32x4*)(Kk + li + 4);
                const f32x4 r0 = *(const LAS f32x4*)(Rr + li), r1 = *(const LAS f32x4*)(Rr + li + 4);
                const float vv = Vv[t * 64 + hi6];
                float sa = 0.f;
#pragma unroll
                for (int i = 0; i < 4; ++i) { sa += S[i] * a0[i]; sa += S[4 + i] * a1[i]; }
                sa = sum8(sa);
                float y = 0.f;
#pragma unroll
                for (int i = 0; i < 4; ++i) {
                    S[i] = S[i] * w0[i] + sa * b0[i] + vv * k0[i]; S[4 + i] = S[4 + i] * w1[i] + sa * b1[i] + vv * k1[i];
                    y += S[i] * r0[i]; y += S[4 + i] * r1[i];
                }
                y = sum8(y);
                if (q8 == 0) Yy[t * 64 + hi6] = y;
            }
            __syncthreads();
            {
                float y[8], mu = 0.f, var = 0.f;
#pragma unroll
                for (int i = 0; i < 8; ++i) { y[i] = Yy[hi6 * 64 + 8 * q8 + i]; mu += y[i]; }
                mu = sum8(mu) * (1.f / 64.f);
#pragma unroll
                for (int i = 0; i < 8; ++i) { y[i] -= mu; var += y[i] * y[i]; }
                var = sum8(var) * (1.f / 64.f);
                const float rs = 1.0f / sqrtf(var + GN_EPS), bon = Bn[hi6];
                float o[8];
#pragma unroll
                for (int i = 0; i < 8; ++i) o[i] = (y[i] * rs * lw_[i] + lb_[i] + bon * Vv[hi6 * 64 + 8 * q8 + i]) * gate[i];
                u32x4 w; w.x = pk2(o[0], o[1]); w.y = pk2(o[2], o[3]); w.z = pk2(o[4], o[5]); w.w = pk2(o[6], o[7]);
                *(u32x4*)(s.YG + off) = w;
            }
            __syncthreads();
        }
    }
}

__device__ __forceinline__ int crow(int r, int hi) { return (r & 3) + 8 * (r >> 2) + 4 * hi; }
__device__ __forceinline__ void attn_v1(const bf16_t* Q, const bf16_t* KA, const bf16_t* VA, bf16_t* O, const float* sinks, int gw, int NGW, int lane) {
    const int q = lane & 31, hi = lane >> 5;
    for (int unit = gw; unit < BATCH * NH * (SEQ / 32); unit += NGW) {
        const int qb = unit & 63, hq = (unit >> 6) & 15, b = unit >> 10, kvh = hq >> 2, t0 = qb * 32;
        const size_t rowb = (size_t)b * SEQ;
        bf16x8 qf[4];
#pragma unroll
        for (int ks = 0; ks < 4; ++ks) qf[ks] = *(const bf16x8*)(Q + (rowb + t0 + q) * D + hq * 64 + ks * 16 + hi * 8);
        f32x16 sc[5];
        float mx = sinks[hq] * LOG2E;
        const int qpos = t0 + q;
#pragma unroll
        for (int j = 0; j < 5; ++j) {
            const int kb = t0 - 128 + 32 * j; int kr = kb + q; kr = kr < 0 ? 0 : kr;
            f32x16 s = {};
#pragma unroll
            for (int ks = 0; ks < 4; ++ks) { const bf16x8 kf = *(const bf16x8*)(KA + (rowb + kr) * 256 + kvh * 64 + ks * 16 + hi * 8); s = __builtin_amdgcn_mfma_f32_32x32x16_bf16(kf, qf[ks], s, 0, 0, 0); }
#pragma unroll
            for (int r = 0; r < 16; ++r) { const int kpos = kb + crow(r, hi), rel = qpos - kpos; const bool ok = (kpos >= 0) && (rel >= 0) && (rel < 128); s[r] = ok ? s[r] : -INFINITY; mx = fmaxf(mx, s[r]); }
            sc[j] = s;
        }
        mx = fmaxf(mx, __shfl_xor(mx, 32));
        float l = 0.f;
#pragma unroll
        for (int j = 0; j < 5; ++j)
#pragma unroll
            for (int r = 0; r < 16; ++r) { const float p = exp2f(sc[j][r] - mx); sc[j][r] = p; l += p; }
        l += __shfl_xor(l, 32);
        l += exp2f(sinks[hq] * LOG2E - mx);
        f32x16 o[2]; o[0] = f32x16{}; o[1] = f32x16{};
#pragma unroll
        for (int j = 0; j < 5; ++j) {
            const int kb = t0 - 128 + 32 * j;
#pragma unroll
            for (int s2 = 0; s2 < 2; ++s2) {
                bf16x8 pf;
#pragma unroll
                for (int e = 0; e < 8; ++e) pf[e] = (short)f2bf(sc[j][8 * s2 + e]);
#pragma unroll
                for (int dt = 0; dt < 2; ++dt) {
                    bf16x8 vf;
#pragma unroll
                    for (int e = 0; e < 8; ++e) { int key = kb + 16 * s2 + 8 * (e >> 2) + 4 * hi + (e & 3); key = key < 0 ? 0 : key; vf[e] = (short)VA[(rowb + key) * 256 + kvh * 64 + dt * 32 + q]; }
                    o[dt] = __builtin_amdgcn_mfma_f32_32x32x16_bf16(vf, pf, o[dt], 0, 0, 0);
                }
            }
        }
        const float il = 1.0f / l;
#pragma unroll
        for (int dt = 0; dt < 2; ++dt)
#pragma unroll
            for (int g4 = 0; g4 < 4; ++g4) {
                const int d = dt * 32 + 8 * g4 + 4 * hi;
                u32x2 w; w.x = pk2(o[dt][4 * g4] * il, o[dt][4 * g4 + 1] * il); w.y = pk2(o[dt][4 * g4 + 2] * il, o[dt][4 * g4 + 3] * il);
                *(u32x2*)(O + (rowb + t0 + q) * D + hq * 64 + d) = w;
            }
    }
}

template <class Epi>
__device__ __forceinline__ void run_gemm(LAS unsigned char* lds, const pg8::Gemm& g, int G, const Epi& E) {
    int tid = threadIdx.x; asm volatile("" : "+v"(tid));
#ifndef DIS_GEMM
    pg8::gemm_simple<Epi>(g, G, (int)blockIdx.x, E, tid);
#endif
}

__global__ void __launch_bounds__(NWAVES * 64, 2) fwd_kernel(Args args) {
    extern __shared__ __attribute__((aligned(16))) unsigned char lds_raw[];
    LAS unsigned char* lds = (LAS unsigned char*)lds_raw;
    volatile LAS unsigned* MISC = (volatile LAS unsigned*)(lds + MISC_OFF);
    const int G = gridDim.x, bx = blockIdx.x;
    const int vcu = (G % 8 == 0) ? (bx % 8) * (G / 8) + bx / 8 : bx;
    const int NGW = G * NWAVES;
    unsigned char* ws = args.ws;
    unsigned* ctl = (unsigned*)(ws + WS_CTL);
    for (int u = threadIdx.x; u < (LDS_BYTES - LDSCTL_OFF) / 4; u += NWAVES * 64) ((LAS unsigned*)(lds + LDSCTL_OFF))[u] = 0u;
    __syncthreads();
    XcdBarrier bar; bar.bar = ctl + CW_BAR; bar.x = 0; bar.st = nullptr;
    const int lo = args.ph_lo, hi = args.ph_hi;
    const bool multi = (hi - lo) > 1;
    if (multi) bar = xcd_barrier_post(ctl + CW_BAR, MISC + 8);
    int ph = 0;
#define PH_BEGIN if (ph >= lo && ph < hi) { int tid = threadIdx.x; asm volatile("" : "+v"(tid)); const int lane = tid & 63, wave = __builtin_amdgcn_readfirstlane(tid >> 6); const int gw = vcu * NWAVES + wave; \
        LAS float* scr = (LAS float*)(lds + RING_OFF + wave * 16384); (void)lane; (void)gw; (void)scr;
#define PH_END } if (ph >= lo && ph + 1 < hi) xcd_barrier(bar); ++ph;

    float* X = args.out;
    bf16_t* XN = (bf16_t*)(ws + WS_XN);
    const float* rope = (const float*)(ws + WS_ROPE);

    PH_BEGIN
        cvt_rwkv(args, 0, ws, scr, gw, NGW, lane);
        cvt_ffn(args, 0, ws, scr, gw, NGW, lane);
        cvt_attn(args, 0, ws, scr, gw, NGW, lane);
        cvt_ffn(args, 1, ws, scr, gw, NGW, lane);
        for (int e = bx * 512 + tid; e < SEQ * 8; e += G * 512) {
            const int pos = e >> 3, i = e & 7;
            const float inv_freq = (float)exp2(-(double)i * 0.125 * 18.931568569324174);
            const float ang = (float)pos * inv_freq;
            ((float*)(ws + WS_ROPE))[e] = (float)cos((double)ang); ((float*)(ws + WS_ROPE))[SEQ * 8 + e] = (float)sin((double)ang);
        }
        for (int e = bx * 512 + tid; e < BATCH * D / 2; e += G * 512) { const int b = e / (D / 2), c = e % (D / 2); ((unsigned*)(XN + (size_t)b * (SEQ + 1) * D))[c] = 0u; }
        norm_rows(args.in[I_X], args.in[I_NORMG], XN, gw, NGW, lane);
    PH_END

    for (int layer = 0; layer < 4; ++layer) {
        const int j = layer >> 1;
        const float* ng = args.in[I_NORMG] + (size_t)layer * 4 * D;
        const float* xin = (layer == 0) ? args.in[I_X] : X;
        if ((layer & 1) == 0) {
            PH_BEGIN
                pg8::Gemm g{XN, (const bf16_t*)(ws + WS_WBIG), M, NBIG, KBIG, D, KBIG, 2, 1 << 30, 0};
                epi::BigOut E{ws, layer == 0 ? WS_VF : WS_V};
                run_gemm(lds, g, G, E);
            PH_END
            PH_BEGIN
                pg8::Gemm g{(const bf16_t*)(ws + WS_L1), (const bf16_t*)(ws + WS_WL2), M, NL2, KL2, LDL1, KL2, 0, 12, 256};
                epi::L2Out E{ws, (const float*)(ws + WS_BIAS4)};
                run_gemm(lds, g, G, E);
            PH_END
            PH_BEGIN
                ScanArgs s{(const bf16_t*)(ws + WS_R), (const bf16_t*)(ws + WS_K), (const bf16_t*)(ws + (layer == 0 ? WS_VF : WS_V)), (const bf16_t*)(ws + WS_VF), (const bf16_t*)(ws + WS_LW),
                           (const bf16_t*)(ws + WS_AG), (const bf16_t*)(ws + WS_GG), (const bf16_t*)(ws + WS_VG), (bf16_t*)(ws + WS_YG),
                           args.in[I_KK] + j * D, args.in[I_KA] + j * D, args.in[I_RK] + j * D, args.in[I_LNW] + j * D, args.in[I_LNB] + j * D, layer == 2 ? 1 : 0};
#ifndef DIS_SCAN
                scan_v1(s, lds, bx, G);
#endif
                if (layer == 2) { __syncthreads(); cvt_attn(args, 1, ws, scr, gw, NGW, lane); cvt_ffn(args, 3, ws, scr, gw, NGW, lane); }
            PH_END
            PH_BEGIN
                pg8::Gemm g{(const bf16_t*)(ws + WS_YG), (const bf16_t*)(ws + WS_WOR), M, D, D, D, D, 0, 1 << 30, 0};
                epi::Bf16Out E{(bf16_t*)(ws + WS_TMP), D, nullptr};
                run_gemm(lds, g, G, E);
            PH_END
        } else {
            PH_BEGIN
                pg8::Gemm g{XN, (const bf16_t*)(ws + WS_WQKV), M, NQKV, D, D, D, 1, 1 << 30, 0};
                epi::QkvOut E{ws, args.in[I_BQKV] + (size_t)j * NQKV, rope};
                run_gemm(lds, g, G, E);
            PH_END
            PH_BEGIN
#ifndef DIS_ATTN
                attn_v1((const bf16_t*)(ws + WS_Q), (const bf16_t*)(ws + WS_KA), (const bf16_t*)(ws + WS_VA), (bf16_t*)(ws + WS_O), args.in[I_SINK] + j * NH, gw, NGW, lane);
#endif
                if (layer == 1) { cvt_rwkv(args, 1, ws, scr, gw, NGW, lane); cvt_ffn(args, 2, ws, scr, gw, NGW, lane); }
            PH_END
            PH_BEGIN
                pg8::Gemm g{(const bf16_t*)(ws + WS_O), (const bf16_t*)(ws + WS_WOA), M, D, D, D, D, 0, 1 << 30, 0};
                epi::Bf16Out E{(bf16_t*)(ws + WS_TMP), D, args.in[I_BOA] + (size_t)j * D};
                run_gemm(lds, g, G, E);
            PH_END
        }
        PH_BEGIN
            resnorm_rows((const bf16_t*)(ws + WS_TMP), xin, X, ng + D, ng + 2 * D, (bf16_t*)(ws + WS_XN2), false, gw, NGW, lane);
        PH_END
        PH_BEGIN
            pg8::Gemm g{(const bf16_t*)(ws + WS_XN2), (const bf16_t*)(ws + ((layer & 1) ? WS_WGU_B : WS_WGU_A)), M, 2 * DFF, D, D, D, 0, 1 << 30, 0};
            epi::SwigluOut E{(bf16_t*)(ws + WS_H)};
            run_gemm(lds, g, G, E);
        PH_END
        PH_BEGIN
            pg8::Gemm g{(const bf16_t*)(ws + WS_H), (const bf16_t*)(ws + ((layer & 1) ? WS_WD_B : WS_WD_A)), M, D, DFF, DFF, DFF, 0, 1 << 30, 0};
            epi::Bf16Out E{(bf16_t*)(ws + WS_TMP), D, nullptr};
            run_gemm(lds, g, G, E);
        PH_END
        PH_BEGIN
            resnorm_rows((const bf16_t*)(ws + WS_TMP), X, X, ng + 3 * D, ng + 4 * D, layer < 3 ? XN : nullptr, true, gw, NGW, lane);
        PH_END
    }
#undef PH_BEGIN
#undef PH_END
}

constexpr int N_PHASES = 1 + 2 * 8 + 2 * 7;

extern "C" void kernel_launch(void* const* d_in, const int* in_sizes, int n_in, void* d_out, int out_size, void* d_ws, size_t ws_size, hipStream_t stream) {
    static int grid = 0;
    if (grid == 0) {
        if (n_in != 28 || out_size != M * D || ws_size < WS_END) { fprintf(stderr, "kernel_launch: unexpected shapes (n_in %d out %d ws %zu)\n", n_in, out_size, ws_size); grid = -1; return; }
        int dev = 0, cus = 0;
        if (hipGetDevice(&dev) != hipSuccess || hipDeviceGetAttribute(&cus, hipDeviceAttributeMultiprocessorCount, dev) != hipSuccess) { grid = -1; return; }
        if (hipFuncSetAttribute((const void*)fwd_kernel, hipFuncAttributeMaxDynamicSharedMemorySize, LDS_BYTES) != hipSuccess) { fprintf(stderr, "kernel_launch: hipFuncSetAttribute failed\n"); grid = -1; return; }
        int per_cu = 0;
        if (hipOccupancyMaxActiveBlocksPerMultiprocessor(&per_cu, (const void*)fwd_kernel, NWAVES * 64, LDS_BYTES) != hipSuccess || per_cu < 1) { fprintf(stderr, "kernel_launch: occupancy query says %d\n", per_cu); }
        (void)hipGetLastError();
        grid = cus;
    }
    if (grid < 0) return;
    if (hipMemsetAsync((char*)d_ws + WS_CTL, 0, CTL_ZERO_BYTES, stream) != hipSuccess) return;
    Args a{};
    for (int i = 0; i < 28; ++i) a.in[i] = (const float*)d_in[i];
    a.out = (float*)d_out; a.ws = (unsigned char*)d_ws;
#if MK_N_LAUNCHES == 1
    a.ph_lo = 0; a.ph_hi = N_PHASES;
    hipLaunchKernelGGL(fwd_kernel, dim3(grid), dim3(NWAVES * 64), LDS_BYTES, stream, a);
#else
    for (int p = 0; p < N_PHASES; ++p) { a.ph_lo = p; a.ph_hi = p + 1; hipLaunchKernelGGL(fwd_kernel, dim3(grid), dim3(NWAVES * 64), LDS_BYTES, stream, a); }
#endif
}
```

```cpp
#include <hip/hip_runtime.h>
#include <cstdio>
#include <cstdint>

#ifndef MK_N_LAUNCHES
#define MK_N_LAUNCHES 1
#endif
#ifndef USE_PG8
#define USE_PG8 0
#endif

#define LAS __attribute__((address_space(3)))
#define GAS __attribute__((address_space(1)))
typedef unsigned short bf16_t;
typedef short bf16x8 __attribute__((ext_vector_type(8)));
typedef float f32x4 __attribute__((ext_vector_type(4)));
typedef float f32x16 __attribute__((ext_vector_type(16)));
typedef unsigned u32x4 __attribute__((ext_vector_type(4)));
typedef unsigned u32x2 __attribute__((ext_vector_type(2)));

constexpr int BATCH = 8, SEQ = 2048, D = 1024, M = BATCH * SEQ, DFF = 2816, NH = 16, HD = 64, NKV = 4;
constexpr int NBIG = 3584;
constexpr int KBIG = 2048;
constexpr int NL2 = 4096, KL2 = 256, LDL1 = 512;
constexpr int NQKV = 1536;
constexpr float RMS_EPS = 1e-6f, GN_EPS = 64e-5f;
constexpr float LOG2E = 1.4426950408889634f;
constexpr float QSCALE = 0.125f * LOG2E;

constexpr size_t MiB = 1u << 20;
constexpr size_t WS_CTL = 0, CTL_ZERO_BYTES = 1 * MiB;
constexpr size_t WS_ROPE = 1 * MiB;
constexpr size_t WS_BIAS4 = 1 * MiB + 512 * 1024;
constexpr size_t WS_WBIG = 2 * MiB, WS_WL2 = 16 * MiB, WS_WOR = 18 * MiB;
constexpr size_t WS_WQKV = 20 * MiB, WS_WOA = 23 * MiB;
constexpr size_t WS_WGU_A = 25 * MiB, WS_WD_A = 36 * MiB;
constexpr size_t WS_WGU_B = 42 * MiB, WS_WD_B = 53 * MiB;
constexpr size_t WS_XCH = 59 * MiB;
constexpr size_t WS_XN = 64 * MiB;
constexpr size_t WS_R = 97 * MiB, WS_K = 129 * MiB, WS_V = 161 * MiB, WS_VF = 193 * MiB, WS_AG = 225 * MiB, WS_GG = 257 * MiB, WS_VG = 289 * MiB, WS_L1 = 321 * MiB, WS_END = 337 * MiB;
constexpr size_t WS_LW = WS_XN, WS_YG = WS_R, WS_XN2 = WS_K, WS_TMP = WS_V, WS_H = WS_AG;
constexpr size_t WS_Q = WS_R, WS_KA = WS_K, WS_VA = WS_K + 8 * MiB, WS_O = WS_AG;
static_assert(WS_WBIG + (size_t)NBIG * KBIG * 2 <= WS_WL2 && WS_WL2 + (size_t)NL2 * KL2 * 2 <= WS_WOR && WS_WOR + (size_t)D * D * 2 <= WS_WQKV, "ws map 1");
static_assert(WS_WQKV + (size_t)NQKV * D * 2 <= WS_WOA && WS_WOA + (size_t)D * D * 2 <= WS_WGU_A, "ws map 2");
static_assert(WS_WGU_A + (size_t)2 * DFF * D * 2 <= WS_WD_A && WS_WD_A + (size_t)D * DFF * 2 <= WS_WGU_B && WS_WGU_B + (size_t)2 * DFF * D * 2 <= WS_WD_B && WS_WD_B + (size_t)D * DFF * 2 <= WS_XCH, "ws map 3");
static_assert(WS_XN + (size_t)(BATCH * (SEQ + 1)) * D * 2 <= WS_R && WS_H + (size_t)M * DFF * 2 <= WS_L1, "ws map 4");

constexpr int CW_TMO = 0, CW_CODE = 1, CW_BAR = 4096;

#define LDS_WAIT() asm volatile("s_waitcnt lgkmcnt(0)" ::: "memory")
#define VM_WAIT() asm volatile("s_waitcnt vmcnt(0)" ::: "memory")
#define RLX_AGENT __ATOMIC_RELAXED, __HIP_MEMORY_SCOPE_AGENT
__device__ __forceinline__ unsigned f2bf(float f) { unsigned u = __builtin_bit_cast(unsigned, f); return (u + 0x7fffu + ((u >> 16) & 1u)) >> 16; }
__device__ __forceinline__ unsigned pk2(float lo, float hi) { return f2bf(lo) | (f2bf(hi) << 16); }
__device__ __forceinline__ float bf2f(unsigned short b) { return __builtin_bit_cast(float, (unsigned)b << 16); }
__device__ __forceinline__ float bflo(unsigned w) { return __builtin_bit_cast(float, w << 16); }
__device__ __forceinline__ float bfhi(unsigned w) { return __builtin_bit_cast(float, w & 0xffff0000u); }
__device__ __forceinline__ float sigmoidf_(float x) { return 1.0f / (1.0f + __expf(-x)); }
__device__ __forceinline__ float tanh_fast(float x) { const float e = __expf(2.0f * fminf(fmaxf(x, -15.f), 15.f)); return (e - 1.0f) / (e + 1.0f); }
__device__ __forceinline__ float logdecay(float u) { const float z = -u; const float sp = fmaxf(z, 0.f) + __logf(1.0f + __expf(-fabsf(z))); return -__expf(-sp - 0.5f); }
__device__ __forceinline__ float wave_sum(float v) {
#pragma unroll
    for (int o = 1; o < 64; o <<= 1) v += __shfl_xor(v, o);
    return v;
}
__device__ __forceinline__ float sum8(float v) { v += __shfl_xor(v, 1); v += __shfl_xor(v, 2); v += __shfl_xor(v, 4); return v; }
__device__ __forceinline__ void unpack8(const u32x4 w, float (&o)[8]) { o[0] = bflo(w.x); o[1] = bfhi(w.x); o[2] = bflo(w.y); o[3] = bfhi(w.y); o[4] = bflo(w.z); o[5] = bfhi(w.z); o[6] = bflo(w.w); o[7] = bfhi(w.w); }

namespace pg8 {
constexpr int BM = 256, BK = 64, HALF = 128, HTB = HALF * BK * 2, STAGE_BYTES = 8 * HTB, NXCD = 8, WGM = 8;
__host__ __device__ __forceinline__ int lds_byte(int r, int c) { const int st = (r >> 4) * 2 + (c >> 5), rr = r & 15, cc = c & 31, ob = rr * 64 + cc * 2; return st * 1024 + (ob ^ (((ob >> 9) & 1) << 5)); }
__host__ __device__ __forceinline__ void stage_rc(int b, int& R, int& C) { const int st = b / 1024, sb = b % 1024, swz = sb ^ (((sb >> 9) & 1) << 5); R = (st >> 1) * 16 + swz / 64; C = (st & 1) * 32 + (swz % 64) / 2; }
__host__ __device__ __forceinline__ int perm32(int rho) { const int n = rho >> 4, i = rho & 15; return 8 * (i >> 2) + 4 * n + (i & 3); }

struct Unit { int pm, pn; };
struct Gemm {
    const bf16_t* A; const bf16_t* Bt; int M, N, K, lda, ldb;
    int a_mode;
    int a_coltile, a_coloff;
    __device__ __forceinline__ const char* a_ptr(int pm, int pn) const {
        const size_t row = (size_t)pm * 256 + (a_mode == 0 ? 0 : (pm >> 3) + (a_mode == 1 ? 1 : 0));
        return (const char*)(A + row * lda + (pn >= a_coltile ? a_coloff : 0));
    }
    __device__ __forceinline__ const char* b_ptr(int pn) const { return (const char*)(Bt + (size_t)pn * 256 * ldb); }
};
struct StaticOrder {
    int nM, nN, nwg, G, c;
    __host__ __device__ void init(int M_, int N_, int G_, int c_) { nM = M_ / BM; nN = N_ / BM; nwg = nM * nN; G = G_; c = c_; }
    __host__ __device__ bool next(int i, Unit& u) const {
        const long L = (long)i * G + c; if (L >= nwg) return false;
        int wgid = (int)L; { const int q = nwg / NXCD, r = nwg % NXCD, xcd = wgid % NXCD, off = wgid / NXCD; wgid = (xcd < r ? xcd * (q + 1) : r * (q + 1) + (xcd - r) * q) + off; }
        const int nig = WGM * nN, gid = wgid / nig, fm = gid * WGM, gsz = (nM - fm) < WGM ? (nM - fm) : WGM;
        u.pm = fm + ((wgid % nig) % gsz); u.pn = (wgid % nig) / gsz; return true;
    }
};

template <class Epi>
__device__ __forceinline__ void gemm_simple(const Gemm g, int G, int c, const Epi& E, int tid) {
    const int wid = __builtin_amdgcn_readfirstlane(tid >> 6), lane = tid & 63, wr = wid >> 2, wc = wid & 3, fr = lane & 15, fq = lane >> 4;
    StaticOrder S; S.init(g.M, g.N, G, c);
    Unit u;
    for (int i = 0; S.next(i, u); ++i) {
        f32x4 acc[2][2][4][2];
#pragma unroll
        for (int a = 0; a < 2; ++a)
#pragma unroll
            for (int b = 0; b < 2; ++b)
#pragma unroll
                for (int m = 0; m < 4; ++m)
#pragma unroll
                    for (int n = 0; n < 2; ++n) acc[a][b][m][n] = (f32x4){0.f, 0.f, 0.f, 0.f};
        const char* Ab = g.a_ptr(u.pm, u.pn);
        const char* Bb = g.b_ptr(u.pn);
        const unsigned aoff = (unsigned)((wr * 64 + fr) * g.lda + fq * 8) * 2u;
        unsigned boff[2];
#pragma unroll
        for (int n = 0; n < 2; ++n) { const int rho = 16 * n + fr; boff[n] = (unsigned)((wc * 32 + (Epi::PERM ? perm32(rho) : rho)) * g.ldb + fq * 8) * 2u; }
        const unsigned a16 = (unsigned)(16 * g.lda) * 2u, a128 = 8u * a16, b128 = (unsigned)(128 * g.ldb) * 2u;
#pragma unroll 1
        for (int k0 = 0; k0 < g.K; k0 += 32) {
            bf16x8 b[2][2];
#pragma unroll
            for (int bj = 0; bj < 2; ++bj)
#pragma unroll
                for (int n = 0; n < 2; ++n) b[bj][n] = *(const bf16x8*)(Bb + (boff[n] + bj * b128 + (unsigned)k0 * 2u));
#pragma unroll
            for (int ai = 0; ai < 2; ++ai) {
                bf16x8 a[4];
#pragma unroll
                for (int m = 0; m < 4; ++m) a[m] = *(const bf16x8*)(Ab + (aoff + ai * a128 + m * a16 + (unsigned)k0 * 2u));
#pragma unroll
                for (int bj = 0; bj < 2; ++bj)
#pragma unroll
                    for (int m = 0; m < 4; ++m)
#pragma unroll
                        for (int n = 0; n < 2; ++n) acc[ai][bj][m][n] = __builtin_amdgcn_mfma_f32_16x16x32_bf16(b[bj][n], a[m], acc[ai][bj][m][n], 0, 0, 0);
            }
        }
        asm volatile("" ::: "memory");
        E(acc, u, wr, wc, fr, fq);
    }
}
}

namespace epi {
using pg8::Unit; using pg8::BM; using pg8::HALF;
__device__ __forceinline__ u32x4 pack8(const f32x4 v0, const f32x4 v1) { u32x4 w; w.x = pk2(v0[0], v0[1]); w.y = pk2(v0[2], v0[3]); w.z = pk2(v1[0], v1[1]); w.w = pk2(v1[2], v1[3]); return w; }

struct Bf16Out {
    static constexpr bool PERM = true, AFTER_DRAIN = false;
    bf16_t* O; int ldc; const float* bias;
    __device__ __forceinline__ void operator()(const f32x4 (&acc)[2][2][4][2], const Unit& u, int wr, int wc, int fr, int fq) const {
        const int row0 = u.pm * BM + wr * 64 + fr, col0 = u.pn * BM + wc * 32 + 8 * fq;
#pragma unroll
        for (int bj = 0; bj < 2; ++bj) {
            f32x4 b0 = (f32x4){0.f, 0.f, 0.f, 0.f}, b1 = b0;
            if (bias) { b0 = *(const f32x4*)(bias + col0 + bj * HALF); b1 = *(const f32x4*)(bias + col0 + bj * HALF + 4); }
#pragma unroll
            for (int ai = 0; ai < 2; ++ai)
#pragma unroll
                for (int m = 0; m < 4; ++m) {
                    bf16_t* p = O + (size_t)(row0 + ai * HALF + m * 16) * ldc + col0 + bj * HALF;
                    *(u32x4*)p = pack8(acc[ai][bj][m][0] + b0, acc[ai][bj][m][1] + b1);
                }
        }
    }
};

struct BigOut {
    static constexpr bool PERM = true, AFTER_DRAIN = false;
    unsigned char* ws; size_t v_off;
    __device__ __forceinline__ void operator()(const f32x4 (&acc)[2][2][4][2], const Unit& u, int wr, int wc, int fr, int fq) const {
        const int row0 = u.pm * BM + wr * 64 + fr;
        const int grp = u.pn >> 2;
        size_t boff = WS_R + (size_t)grp * (32 * MiB); if (grp == 2) boff = v_off; if (grp == 3) boff = WS_L1;
        bf16_t* base = (bf16_t*)(ws + boff);
        const int ldc = (grp == 3) ? LDL1 : D, colt = (grp == 3) ? (u.pn - 12) * BM : (u.pn & 3) * BM;
        int act0 = 0, act1 = 0;
        if (u.pn == 12) { act0 = (wc < 2) ? 1 : 0; act1 = 2; }
        const int col0 = colt + wc * 32 + 8 * fq;
#pragma unroll
        for (int bj = 0; bj < 2; ++bj) {
            const int act = bj ? act1 : act0;
#pragma unroll
            for (int ai = 0; ai < 2; ++ai)
#pragma unroll
                for (int m = 0; m < 4; ++m) {
                    f32x4 v0 = acc[ai][bj][m][0], v1 = acc[ai][bj][m][1];
                    if (act == 1) {
#pragma unroll
                        for (int j = 0; j < 4; ++j) { v0[j] = tanh_fast(v0[j]); v1[j] = tanh_fast(v1[j]); }
                    } else if (act == 2) {
#pragma unroll
                        for (int j = 0; j < 4; ++j) { v0[j] = sigmoidf_(v0[j]); v1[j] = sigmoidf_(v1[j]); }
                    }
                    *(u32x4*)(base + (size_t)(row0 + ai * HALF + m * 16) * ldc + col0 + bj * HALF) = pack8(v0, v1);
                }
        }
    }
};

struct L2Out {
    static constexpr bool PERM = true, AFTER_DRAIN = false;
    unsigned char* ws; const float* bias4;
    __device__ __forceinline__ void operator()(const f32x4 (&acc)[2][2][4][2], const Unit& u, int wr, int wc, int fr, int fq) const {
        const int row0 = u.pm * BM + wr * 64 + fr, grp = u.pn >> 2, col0 = (u.pn & 3) * BM + wc * 32 + 8 * fq;
        bf16_t* base = (bf16_t*)(ws + (grp == 0 ? WS_LW : WS_AG + (size_t)(grp - 1) * (32 * MiB)));
        const float* bias = bias4 + grp * D;
#pragma unroll
        for (int bj = 0; bj < 2; ++bj) {
            const f32x4 b0 = *(const f32x4*)(bias + col0 + bj * HALF), b1 = *(const f32x4*)(bias + col0 + bj * HALF + 4);
#pragma unroll
            for (int ai = 0; ai < 2; ++ai)
#pragma unroll
                for (int m = 0; m < 4; ++m) {
                    f32x4 v0_ = acc[ai][bj][m][0] + b0, v1_ = acc[ai][bj][m][1] + b1;
                    if (grp == 0) {
#pragma unroll
                        for (int j = 0; j < 4; ++j) { v0_[j] = logdecay(v0_[j]); v1_[j] = logdecay(v1_[j]); }
                    } else if (grp != 2) {
#pragma unroll
                        for (int j = 0; j < 4; ++j) { v0_[j] = sigmoidf_(v0_[j]); v1_[j] = sigmoidf_(v1_[j]); }
                    }
                    *(u32x4*)(base + (size_t)(row0 + ai * HALF + m * 16) * D + col0 + bj * HALF) = pack8(v0_, v1_);
                }
        }
    }
};

struct QkvOut {
    static constexpr bool PERM = true, AFTER_DRAIN = false;
    unsigned char* ws; const float* bias; const float* rope;
    __device__ __forceinline__ void operator()(const f32x4 (&acc)[2][2][4][2], const Unit& u, int wr, int wc, int fr, int fq) const {
        const int row0 = u.pm * BM + wr * 64 + fr;
        const bool isq = u.pn < 4;
        bf16_t* base = (bf16_t*)(ws + (isq ? WS_Q : WS_KA + (size_t)(u.pn - 4) * (8 * MiB)));
        const int ldc = isq ? D : 256, colt = isq ? u.pn * BM : 0; const float sc = isq ? QSCALE : 1.f;
        const bool rot = (u.pn < 5) && ((wc & 1) == 0) && (fq < 2);
#pragma unroll
        for (int bj = 0; bj < 2; ++bj) {
            const int cl = bj * HALF + wc * 32 + 8 * fq;
            const int scol = u.pn * BM + cl;
            float bv[8];
#pragma unroll
            for (int i = 0; i < 8; ++i) {
                const int dp = (scol + i) & 63; int d = dp;
                if (u.pn < 5 && dp < 16) d = (dp >> 1) + 8 * (dp & 1);
                bv[i] = bias[((scol + i) & ~63) + d];
            }
#pragma unroll
            for (int ai = 0; ai < 2; ++ai)
#pragma unroll
                for (int m = 0; m < 4; ++m) {
                    const int row = row0 + ai * HALF + m * 16;
                    float v[8];
#pragma unroll
                    for (int i = 0; i < 4; ++i) { v[i] = acc[ai][bj][m][0][i] + bv[i]; v[4 + i] = acc[ai][bj][m][1][i] + bv[4 + i]; }
                    if (rot) {
                        const int pos = row & (SEQ - 1);
                        const f32x4 cs = *(const f32x4*)(rope + pos * 8 + 4 * fq), sn = *(const f32x4*)(rope + SEQ * 8 + pos * 8 + 4 * fq);
#pragma unroll
                        for (int i = 0; i < 4; ++i) { const float x1 = v[2 * i], x2 = v[2 * i + 1]; v[2 * i] = x1 * cs[i] - x2 * sn[i]; v[2 * i + 1] = x2 * cs[i] + x1 * sn[i]; }
                    }
                    u32x4 w; w.x = pk2(v[0] * sc, v[1] * sc); w.y = pk2(v[2] * sc, v[3] * sc); w.z = pk2(v[4] * sc, v[5] * sc); w.w = pk2(v[6] * sc, v[7] * sc);
                    *(u32x4*)(base + (size_t)row * ldc + colt + cl) = w;
                }
        }
    }
};

struct SwigluOut {
    static constexpr bool PERM = true, AFTER_DRAIN = false;
    bf16_t* H;
    __device__ __forceinline__ void operator()(const f32x4 (&acc)[2][2][4][2], const Unit& u, int wr, int wc, int fr, int fq) const {
        const int row0 = u.pm * BM + wr * 64 + fr, col0 = u.pn * HALF + wc * 32 + 8 * fq;
#pragma unroll
        for (int ai = 0; ai < 2; ++ai)
#pragma unroll
            for (int m = 0; m < 4; ++m) {
                f32x4 o0, o1;
#pragma unroll
                for (int j = 0; j < 4; ++j) {
                    const float g0 = acc[ai][0][m][0][j], g1 = acc[ai][0][m][1][j];
                    o0[j] = g0 * sigmoidf_(g0) * acc[ai][1][m][0][j]; o1[j] = g1 * sigmoidf_(g1) * acc[ai][1][m][1][j];
                }
                *(u32x4*)(H + (size_t)(row0 + ai * HALF + m * 16) * DFF + col0) = pack8(o0, o1);
            }
    }
};
}

#define XB_TMO      128
#define XB_XCNT(j)  (256  + 64 * (j))
#define XB_XSUB(j)  (1280 + 64 * (j))
#define XB_XGEN(j)  (2304 + 64 * (j))
#define XB_TOP      3328
#define XB_TOPGEN   3392
#define XCD_BAR_WORDS 3456
#define XB_SPIN_CAP (1u << 22)
__device__ __forceinline__ unsigned xb_ld(unsigned* p)              { return __hip_atomic_load(p, __ATOMIC_RELAXED, __HIP_MEMORY_SCOPE_AGENT); }
__device__ __forceinline__ unsigned xb_add(unsigned* p, unsigned v) { return __hip_atomic_fetch_add(p, v, __ATOMIC_RELAXED, __HIP_MEMORY_SCOPE_AGENT); }
__device__ __forceinline__ unsigned xb_xcc_id() { return (unsigned)__builtin_amdgcn_s_getreg((3 << 11) | 20) & 0xFu; }
#define XB_SPIN(cond, bar) do { unsigned _sp = 0; while (cond) { __builtin_amdgcn_s_sleep(1); \
    if ((++_sp & 255u) == 0u) { if (xb_ld(&(bar)[XB_TMO])) break; if (_sp > XB_SPIN_CAP) { atomicAdd(&(bar)[XB_TMO], 1u); break; } } } } while (0)
struct XcdBarrier { unsigned* bar; unsigned x; volatile LAS unsigned* st; };
__device__ __forceinline__ XcdBarrier xcd_barrier_post(unsigned* bar, volatile LAS unsigned* st) {
    XcdBarrier b; b.bar = bar; b.x = xb_xcc_id(); b.st = st;
    if (threadIdx.x == 0) (void)xb_add(&bar[XB_XCNT(b.x)], 1u);
    return b;
}
__device__ __forceinline__ void xcd_barrier_complete(unsigned* bar, unsigned x, unsigned& nloc, unsigned& nx) {
    const unsigned G = gridDim.x * gridDim.y * gridDim.z;
    unsigned sum, cnt, mine, sp = 0u;
    for (;;) {
        sum = 0u; cnt = 0u; mine = 0u;
#pragma unroll
        for (unsigned j = 0; j < 16; ++j) { const unsigned c = xb_ld(&bar[XB_XCNT(j)]); sum += c; cnt += (c > 0u) ? 1u : 0u; mine = (j == x) ? c : mine; }
        if (sum == G) break;
        __builtin_amdgcn_s_sleep(1);
        if ((++sp & 255u) == 0u) { if (xb_ld(&bar[XB_TMO])) break; if (sp > XB_SPIN_CAP) { atomicAdd(&bar[XB_TMO], 1u); break; } }
    }
    nloc = mine > 0u ? mine : 1u; nx = cnt > 0u ? cnt : 1u;
}
__device__ __forceinline__ void xcd_barrier(const XcdBarrier& b) {
    asm volatile("s_waitcnt vmcnt(0)" ::: "memory");
    __syncthreads();
    if (threadIdx.x == 0) {
        unsigned* bar = b.bar;
        __builtin_amdgcn_s_waitcnt(0);
        unsigned nloc = b.st[0], nx = b.st[1];
        if (nloc == 0u) { xcd_barrier_complete(bar, b.x, nloc, nx); b.st[0] = nloc; b.st[1] = nx; }
        const unsigned old = xb_add(&bar[XB_XSUB(b.x)], 1u);
        const unsigned gen = old / nloc;
        if (old + 1u == (gen + 1u) * nloc) {
            __builtin_amdgcn_fence(__ATOMIC_RELEASE, "agent");
            asm volatile("s_waitcnt vmcnt(0)" ::: "memory");
            const unsigned og = xb_add(&bar[XB_TOP], 1u);
            const unsigned tg = og / nx;
            if (og + 1u == (tg + 1u) * nx) xb_add(&bar[XB_TOPGEN], 1u);
            else XB_SPIN(xb_ld(&bar[XB_TOPGEN]) == tg, bar);
            __builtin_amdgcn_fence(__ATOMIC_ACQUIRE, "agent");
            xb_add(&bar[XB_XGEN(b.x)], 1u);
            asm volatile("s_waitcnt vmcnt(0)" ::: "memory");
        } else {
            XB_SPIN(xb_ld(&bar[XB_XGEN(b.x)]) == gen, bar);
            __builtin_amdgcn_fence(__ATOMIC_ACQUIRE, "agent");
            asm volatile("s_waitcnt vmcnt(0)" ::: "memory");
        }
    }
    __syncthreads();
}

constexpr int RING_OFF = 0, RING_BYTES = 131072;
constexpr int LDSCTL_OFF = RING_BYTES, MISC_OFF = LDSCTL_OFF + 320;
constexpr int LDS_BYTES = 147456;
constexpr int NWAVES = 8;

struct Args { const float* in[28]; float* out; unsigned char* ws; int ph_lo, ph_hi; };
enum { I_X = 0, I_NORMG, I_XMIX, I_WRKV, I_W0, I_W1, I_W2, I_A0, I_A1, I_A2, I_V0, I_V1, I_V2, I_G1, I_G2, I_KK, I_KA, I_RK, I_LNW, I_LNB, I_WOR,
       I_WQKV, I_BQKV, I_SINK, I_WOA, I_BOA, I_WGU, I_WD };

template <class F>
__device__ __forceinline__ void cvt_matrix(bf16_t* WT, int N, int K, const F& f, LAS float* scr, int gw, int NGW, int lane) {
    const int nblk = N / 32, nitems = nblk * (K / 64);
    for (int it = gw; it < nitems; it += NGW) {
        const int kb = it / nblk, nb = it % nblk, k0 = 64 * kb, n0 = 32 * nb;
#pragma unroll 8
        for (int i = 0; i < 32; ++i) { const int kk = 2 * i + (lane >> 5); scr[kk * 33 + (lane & 31)] = f(n0 + (lane & 31), k0 + kk); }
        LDS_WAIT(); asm volatile("" ::: "memory");
        const int c = lane & 7;
#pragma unroll
        for (int j = 0; j < 4; ++j) { const int n = (lane >> 3) + 8 * j; const LAS float* s = scr + (8 * c) * 33 + n;
            u32x4 o; o.x = pk2(s[0 * 33], s[1 * 33]); o.y = pk2(s[2 * 33], s[3 * 33]); o.z = pk2(s[4 * 33], s[5 * 33]); o.w = pk2(s[6 * 33], s[7 * 33]);
            *(u32x4*)(WT + (size_t)(n0 + n) * K + k0 + 8 * c) = o; }
        LDS_WAIT(); asm volatile("" ::: "memory");
    }
}
struct FBig {
    const float *wrkv, *w1, *a1, *g1, *v1, *mix; int has_v;
    __device__ __forceinline__ float operator()(int n, int k) const {
        const int kk = k & 1023; float w; int mi;
        if (n < 3072) { mi = n >> 10; w = wrkv[((size_t)mi * D + kk) * D + (n & 1023)]; }
        else if (n < 3136) { mi = 3; w = w1[kk * 64 + (n - 3072)]; }
        else if (n < 3200) { mi = 4; w = a1[kk * 64 + (n - 3136)]; }
        else if (n < 3328) { mi = 5; w = g1[kk * 128 + (n - 3200)]; }
        else if (n < 3360 && has_v) { mi = 2; w = v1[kk * 32 + (n - 3328)]; }
        else return 0.f;
        const float mx = mix[mi * D + kk];
        return w * (k < 1024 ? mx : 1.0f - mx);
    }
};
struct FL2 {
    const float *w2, *a2, *g2, *v2; int has_v;
    __device__ __forceinline__ float operator()(int n, int k) const {
        const int grp = n >> 10, c = n & 1023;
        if (grp == 0) return k < 64 ? w2[k * D + c] : 0.f;
        if (grp == 1) return (k >= 64 && k < 128) ? a2[(k - 64) * D + c] : 0.f;
        if (grp == 2) return k >= 128 ? g2[(k - 128) * D + c] : 0.f;
        return (k < 32 && has_v) ? v2[k * D + c] : 0.f;
    }
};
struct FPlain { const float* W; int N;
    __device__ __forceinline__ float operator()(int n, int k) const { return W[(size_t)k * N + n]; } };
struct FQkv { const float* W;
    __device__ __forceinline__ float operator()(int n, int k) const { int sn = n; if (n < 1280) { const int dp = n & 63; if (dp < 16) sn = (n & ~63) + (dp >> 1) + 8 * (dp & 1); } return W[(size_t)k * NQKV + sn]; } };
struct FGu { const float* W;
    __device__ __forceinline__ float operator()(int n, int k) const { const int t = n >> 8, r = n & 255; const int sn = (r < 128) ? t * 128 + r : DFF + t * 128 + (r - 128); return W[(size_t)k * (2 * DFF) + sn]; } };

__device__ __forceinline__ void cvt_rwkv(const Args& a, int j, unsigned char* ws, LAS float* scr, int gw, int NGW, int lane) {
    FBig fb{a.in[I_WRKV] + (size_t)j * 3 * D * D, a.in[I_W1] + (size_t)j * D * 64, a.in[I_A1] + (size_t)j * D * 64, a.in[I_G1] + (size_t)j * D * 128, a.in[I_V1], a.in[I_XMIX] + (size_t)j * 6 * D, j > 0 ? 1 : 0};
    cvt_matrix((bf16_t*)(ws + WS_WBIG), NBIG, KBIG, fb, scr, gw, NGW, lane);
    FL2 f2{a.in[I_W2] + (size_t)j * 64 * D, a.in[I_A2] + (size_t)j * 64 * D, a.in[I_G2] + (size_t)j * 128 * D, a.in[I_V2], j > 0 ? 1 : 0};
    cvt_matrix((bf16_t*)(ws + WS_WL2), NL2, KL2, f2, scr, gw, NGW, lane);
    FPlain fo{a.in[I_WOR] + (size_t)j * D * D, D};
    cvt_matrix((bf16_t*)(ws + WS_WOR), D, D, fo, scr, gw, NGW, lane);
    for (int e = gw * 64 + lane; e < 4 * D; e += NGW * 64) { const int grp = e >> 10, c = e & 1023; float v = 0.f;
        if (grp == 0) v = a.in[I_W0][j * D + c]; else if (grp == 1) v = a.in[I_A0][j * D + c]; else if (grp == 3) v = a.in[I_V0][c];
        ((float*)(ws + WS_BIAS4))[e] = v; }
}
__device__ __forceinline__ void cvt_attn(const Args& a, int j, unsigned char* ws, LAS float* scr, int gw, int NGW, int lane) {
    FQkv fq{a.in[I_WQKV] + (size_t)j * D * NQKV};
    cvt_matrix((bf16_t*)(ws + WS_WQKV), NQKV, D, fq, scr, gw, NGW, lane);
    FPlain fo{a.in[I_WOA] + (size_t)j * D * D, D};
    cvt_matrix((bf16_t*)(ws + WS_WOA), D, D, fo, scr, gw, NGW, lane);
}
__device__ __forceinline__ void cvt_ffn(const Args& a, int i, unsigned char* ws, LAS float* scr, int gw, int NGW, int lane) {
    const size_t ogu = (i & 1) ? WS_WGU_B : WS_WGU_A, od = (i & 1) ? WS_WD_B : WS_WD_A;
    FGu fg{a.in[I_WGU] + (size_t)i * D * 2 * DFF};
    cvt_matrix((bf16_t*)(ws + ogu), 2 * DFF, D, fg, scr, gw, NGW, lane);
    FPlain fd{a.in[I_WD] + (size_t)i * DFF * D, D};
    cvt_matrix((bf16_t*)(ws + od), D, DFF, fd, scr, gw, NGW, lane);
}

__device__ __forceinline__ size_t xn_row(int m) { return (size_t)m + (m >> 11) + 1; }
__device__ __forceinline__ void norm_rows(const float* x, const float* g, bf16_t* xn, int gw, int NGW, int lane) {
    f32x4 gv[4];
#pragma unroll
    for (int j = 0; j < 4; ++j) gv[j] = *((const f32x4*)g + lane + 64 * j);
    for (int m = gw; m < M; m += NGW) {
        const f32x4* xr = (const f32x4*)(x + (size_t)m * D) + lane;
        f32x4 v[4]; float s = 0.f;
#pragma unroll
        for (int j = 0; j < 4; ++j) { v[j] = xr[64 * j]; s += (v[j][0] * v[j][0] + v[j][1] * v[j][1]) + (v[j][2] * v[j][2] + v[j][3] * v[j][3]); }
        const float rstd = 1.0f / sqrtf(wave_sum(s) * (1.f / D) + RMS_EPS);
        u32x2* o = (u32x2*)(xn + xn_row(m) * D) + lane;
#pragma unroll
        for (int j = 0; j < 4; ++j) { u32x2 w; w.x = pk2(v[j][0] * rstd * gv[j][0], v[j][1] * rstd * gv[j][1]); w.y = pk2(v[j][2] * rstd * gv[j][2], v[j][3] * rstd * gv[j][3]); o[64 * j] = w; }
    }
}
__device__ __forceinline__ void resnorm_rows(const bf16_t* tmp, const float* xin, float* xout, const float* ga, const float* gb, bf16_t* xn, bool guard, int gw, int NGW, int lane) {
    for (int m = gw; m < M; m += NGW) {
        const u32x2* tr = (const u32x2*)(tmp + (size_t)m * D) + lane;
        const f32x4* xr = (const f32x4*)(xin + (size_t)m * D) + lane;
        f32x4 t[4], v[4]; float s = 0.f;
#pragma unroll
        for (int j = 0; j < 4; ++j) { const u32x2 w = tr[64 * j]; t[j] = (f32x4){bflo(w.x), bfhi(w.x), bflo(w.y), bfhi(w.y)}; v[j] = xr[64 * j];
            s += (t[j][0] * t[j][0] + t[j][1] * t[j][1]) + (t[j][2] * t[j][2] + t[j][3] * t[j][3]); }
        const float r1 = 1.0f / sqrtf(wave_sum(s) * (1.f / D) + RMS_EPS);
        float s2 = 0.f;
        f32x4* xo = (f32x4*)(xout + (size_t)m * D) + lane;
#pragma unroll
        for (int j = 0; j < 4; ++j) { const f32x4 gv = *((const f32x4*)ga + lane + 64 * j); v[j] = v[j] + t[j] * r1 * gv; xo[64 * j] = v[j];
            s2 += (v[j][0] * v[j][0] + v[j][1] * v[j][1]) + (v[j][2] * v[j][2] + v[j][3] * v[j][3]); }
        if (xn) {
            const float r2 = 1.0f / sqrtf(wave_sum(s2) * (1.f / D) + RMS_EPS);
            u32x2* o = (u32x2*)(xn + (guard ? xn_row(m) : (size_t)m) * D) + lane;
#pragma unroll
            for (int j = 0; j < 4; ++j) { const f32x4 gv = *((const f32x4*)gb + lane + 64 * j); u32x2 w; w.x = pk2(v[j][0] * r2 * gv[0], v[j][1] * r2 * gv[1]); w.y = pk2(v[j][2] * r2 * gv[2], v[j][3] * r2 * gv[3]); o[64 * j] = w; }
        }
    }
}

struct ScanArgs { const bf16_t *R, *K, *V, *VF, *LW, *AG, *GG, *VG; bf16_t* YG; const float *k_k, *k_a, *r_k, *lnw, *lnb; int layer2; };
__device__ __forceinline__ void scan_v1(const ScanArgs& s, LAS unsigned char* lds, int unit0, int ustride) {
    LAS float* Wd = (LAS float*)lds;
    LAS float* Aa = Wd + 4096;
    LAS float* Bb = Aa + 4096;
    LAS float* Kk = Bb + 4096;
    LAS float* Rr = Kk + 4096;
    LAS float* Vv = Rr + 4096;
    LAS float* Yy = Vv + 4096;
    LAS float* Bn = Yy + 4096;
    int tid = threadIdx.x; asm volatile("" : "+v"(tid));
    const int q8 = tid & 7, hi6 = tid >> 3;
    for (int unit = unit0; unit < BATCH * NH; unit += ustride) {
        const int b = unit >> 4, h = unit & 15, col = h * 64 + 8 * q8;
        float kkw[8], kaw[8], rkw[8], lw_[8], lb_[8];
#pragma unroll
        for (int i = 0; i < 8; ++i) { kkw[i] = s.k_k[col + i]; kaw[i] = s.k_a[col + i]; rkw[i] = s.r_k[col + i]; lw_[i] = s.lnw[col + i]; lb_[i] = s.lnb[col + i]; }
        float S[8];
#pragma unroll
        for (int i = 0; i < 8; ++i) S[i] = 0.f;
        for (int c = 0; c < SEQ / 64; ++c) {
            const size_t off = ((size_t)b * SEQ + c * 64 + hi6) * D + col;
            float gate[8];
            {
                float r[8], k[8], v[8], lw[8], ag[8];
                unpack8(*(const u32x4*)(s.R + off), r); unpack8(*(const u32x4*)(s.K + off), k); unpack8(*(const u32x4*)(s.V + off), v);
                unpack8(*(const u32x4*)(s.LW + off), lw); unpack8(*(const u32x4*)(s.AG + off), ag); unpack8(*(const u32x4*)(s.GG + off), gate);
                if (s.layer2) { float vf[8], vg[8]; unpack8(*(const u32x4*)(s.VF + off), vf); unpack8(*(const u32x4*)(s.VG + off), vg);
#pragma unroll
                    for (int i = 0; i < 8; ++i) v[i] = v[i] + (vf[i] - v[i]) * vg[i]; }
                float kk[8], ss = 0.f, bon = 0.f;
#pragma unroll
                for (int i = 0; i < 8; ++i) { kk[i] = k[i] * kkw[i]; ss += kk[i] * kk[i]; }
                ss = sum8(ss);
                const float inv = 1.0f / fmaxf(sqrtf(ss), 1e-12f);
#pragma unroll
                for (int i = 0; i < 8; ++i) {
                    kk[i] *= inv;
                    const float kp = k[i] * (1.0f + (ag[i] - 1.0f) * kaw[i]);
                    bon += r[i] * kp * rkw[i];
                    const int li = hi6 * 64 + 8 * q8 + i;
                    Wd[li] = __expf(lw[i]); Aa[li] = -kk[i]; Bb[li] = kk[i] * ag[i]; Kk[li] = kp; Rr[li] = r[i]; Vv[li] = v[i];
                }
                bon = sum8(bon);
                if (q8 == 0) Bn[hi6] = bon;
            }
            __syncthreads();
            for (int t = 0; t < 64; ++t) {
                const int li = t * 64 + 8 * q8;
                const f32x4 w0 = *(const LAS f32x4*)(Wd + li), w1 = *(const LAS f32x4*)(Wd + li + 4), a0 = *(const LAS f32x4*)(Aa + li), a1 = *(const LAS f32x4*)(Aa + li + 4);
                const f32x4 b0 = *(const LAS f32x4*)(Bb + li), b1 = *(const LAS f32x4*)(Bb + li + 4), k0 = *(const LAS f32x4*)(Kk + li), k1 = *(const LAS f32x4*)(Kk + li + 4);
                const f32x4 r0 = *(const LAS f32x4*)(Rr + li), r1 = *(const LAS f32x4*)(Rr + li + 4);
                const float vv = Vv[t * 64 + hi6];
                float sa = 0.f;
#pragma unroll
                for (int i = 0; i < 4; ++i) { sa += S[i] * a0[i]; sa += S[4 + i] * a1[i]; }
                sa = sum8(sa);
                float y = 0.f;
#pragma unroll
                for (int i = 0; i < 4; ++i) {
                    S[i] = S[i] * w0[i] + sa * b0[i] + vv * k0[i]; S[4 + i] = S[4 + i] * w1[i] + sa * b1[i] + vv * k1[i];
                    y += S[i] * r0[i]; y += S[4 + i] * r1[i];
                }
                y = sum8(y);
                if (q8 == 0) Yy[t * 64 + hi6] = y;
            }
            __syncthreads();
            {
                float y[8], mu = 0.f, var = 0.f;
#pragma unroll
                for (int i = 0; i < 8; ++i) { y[i] = Yy[hi6 * 64 + 8 * q8 + i]; mu += y[i]; }
                mu = sum8(mu) * (1.f / 64.f);
#pragma unroll
                for (int i = 0; i < 8; ++i) { y[i] -= mu; var += y[i] * y[i]; }
                var = sum8(var) * (1.f / 64.f);
                const float rs = 1.0f / sqrtf(var + GN_EPS), bon = Bn[hi6];
                float o[8];
#pragma unroll
                for (int i = 0; i < 8; ++i) o[i] = (y[i] * rs * lw_[i] + lb_[i] + bon * Vv[hi6 * 64 + 8 * q8 + i]) * gate[i];
                u32x4 w; w.x = pk2(o[0], o[1]); w.y = pk2(o[2], o[3]); w.z = pk2(o[4], o[5]); w.w = pk2(o[6], o[7]);
                *(u32x4*)(s.YG + off) = w;
            }
            __syncthreads();
        }
    }
}

__device__ __forceinline__ int crow(int r, int hi) { return (r & 3) + 8 * (r >> 2) + 4 * hi; }
__device__ __forceinline__ void attn_v1(const bf16_t* Q, const bf16_t* KA, const bf16_t* VA, bf16_t* O, const float* sinks, int gw, int NGW, int lane) {
    const int q = lane & 31, hi = lane >> 5;
    for (int unit = gw; unit < BATCH * NH * (SEQ / 32); unit += NGW) {
        const int qb = unit & 63, hq = (unit >> 6) & 15, b = unit >> 10, kvh = hq >> 2, t0 = qb * 32;
        const size_t rowb = (size_t)b * SEQ;
        bf16x8 qf[4];
#pragma unroll
        for (int ks = 0; ks < 4; ++ks) qf[ks] = *(const bf16x8*)(Q + (rowb + t0 + q) * D + hq * 64 + ks * 16 + hi * 8);
        f32x16 sc[5];
        float mx = sinks[hq] * LOG2E;
        const int qpos = t0 + q;
#pragma unroll
        for (int j = 0; j < 5; ++j) {
            const int kb = t0 - 128 + 32 * j; int kr = kb + q; kr = kr < 0 ? 0 : kr;
            f32x16 s = {};
#pragma unroll
            for (int ks = 0; ks < 4; ++ks) { const bf16x8 kf = *(const bf16x8*)(KA + (rowb + kr) * 256 + kvh * 64 + ks * 16 + hi * 8); s = __builtin_amdgcn_mfma_f32_32x32x16_bf16(kf, qf[ks], s, 0, 0, 0); }
#pragma unroll
            for (int r = 0; r < 16; ++r) { const int kpos = kb + crow(r, hi), rel = qpos - kpos; const bool ok = (kpos >= 0) && (rel >= 0) && (rel < 128); s[r] = ok ? s[r] : -INFINITY; mx = fmaxf(mx, s[r]); }
            sc[j] = s;
        }
        mx = fmaxf(mx, __shfl_xor(mx, 32));
        float l = 0.f;
#pragma unroll
        for (int j = 0; j < 5; ++j)
#pragma unroll
            for (int r = 0; r < 16; ++r) { const float p = exp2f(sc[j][r] - mx); sc[j][r] = p; l += p; }
        l += __shfl_xor(l, 32);
        l += exp2f(sinks[hq] * LOG2E - mx);
        f32x16 o[2]; o[0] = f32x16{}; o[1] = f32x16{};
#pragma unroll
        for (int j = 0; j < 5; ++j) {
            const int kb = t0 - 128 + 32 * j;
#pragma unroll
            for (int s2 = 0; s2 < 2; ++s2) {
                bf16x8 pf;
#pragma unroll
                for (int e = 0; e < 8; ++e) pf[e] = (short)f2bf(sc[j][8 * s2 + e]);
#pragma unroll
                for (int dt = 0; dt < 2; ++dt) {
                    bf16x8 vf;
#pragma unroll
                    for (int e = 0; e < 8; ++e) { int key = kb + 16 * s2 + 8 * (e >> 2) + 4 * hi + (e & 3); key = key < 0 ? 0 : key; vf[e] = (short)VA[(rowb + key) * 256 + kvh * 64 + dt * 32 + q]; }
                    o[dt] = __builtin_amdgcn_mfma_f32_32x32x16_bf16(vf, pf, o[dt], 0, 0, 0);
                }
            }
        }
        const float il = 1.0f / l;
#pragma unroll
        for (int dt = 0; dt < 2; ++dt)
#pragma unroll
            for (int g4 = 0; g4 < 4; ++g4) {
                const int d = dt * 32 + 8 * g4 + 4 * hi;
                u32x2 w; w.x = pk2(o[dt][4 * g4] * il, o[dt][4 * g4 + 1] * il); w.y = pk2(o[dt][4 * g4 + 2] * il, o[dt][4 * g4 + 3] * il);
                *(u32x2*)(O + (rowb + t0 + q) * D + hq * 64 + d) = w;
            }
    }
}

template <class Epi>
__device__ __forceinline__ void run_gemm(LAS unsigned char* lds, const pg8::Gemm& g, int G, const Epi& E) {
    int tid = threadIdx.x; asm volatile("" : "+v"(tid));
#ifndef DIS_GEMM
    pg8::gemm_simple<Epi>(g, G, (int)blockIdx.x, E, tid);
#endif
}

__global__ void __launch_bounds__(NWAVES * 64, 2) fwd_kernel(Args args) {
    extern __shared__ __attribute__((aligned(16))) unsigned char lds_raw[];
    LAS unsigned char* lds = (LAS unsigned char*)lds_raw;
    volatile LAS unsigned* MISC = (volatile LAS unsigned*)(lds + MISC_OFF);
    const int G = gridDim.x, bx = blockIdx.x;
    const int vcu = (G % 8 == 0) ? (bx % 8) * (G / 8) + bx / 8 : bx;
    const int NGW = G * NWAVES;
    unsigned char* ws = args.ws;
    unsigned* ctl = (unsigned*)(ws + WS_CTL);
    for (int u = threadIdx.x; u < (LDS_BYTES - LDSCTL_OFF) / 4; u += NWAVES * 64) ((LAS unsigned*)(lds + LDSCTL_OFF))[u] = 0u;
    __syncthreads();
    XcdBarrier bar; bar.bar = ctl + CW_BAR; bar.x = 0; bar.st = nullptr;
    const int lo = args.ph_lo, hi = args.ph_hi;
    const bool multi = (hi - lo) > 1;
    if (multi) bar = xcd_barrier_post(ctl + CW_BAR, MISC + 8);
    int ph = 0;
#define PH_BEGIN if (ph >= lo && ph < hi) { int tid = threadIdx.x; asm volatile("" : "+v"(tid)); const int lane = tid & 63, wave = __builtin_amdgcn_readfirstlane(tid >> 6); const int gw = vcu * NWAVES + wave; \
        LAS float* scr = (LAS float*)(lds + RING_OFF + wave * 16384); (void)lane; (void)gw; (void)scr;
#define PH_END } if (ph >= lo && ph + 1 < hi) xcd_barrier(bar); ++ph;

    float* X = args.out;
    bf16_t* XN = (bf16_t*)(ws + WS_XN);
    const float* rope = (const float*)(ws + WS_ROPE);

    PH_BEGIN
        cvt_rwkv(args, 0, ws, scr, gw, NGW, lane);
        cvt_ffn(args, 0, ws, scr, gw, NGW, lane);
        cvt_attn(args, 0, ws, scr, gw, NGW, lane);
        cvt_ffn(args, 1, ws, scr, gw, NGW, lane);
        for (int e = bx * 512 + tid; e < SEQ * 8; e += G * 512) {
            const int pos = e >> 3, i = e & 7;
            const float inv_freq = (float)exp2(-(double)i * 0.125 * 18.931568569324174);
            const float ang = (float)pos * inv_freq;
            ((float*)(ws + WS_ROPE))[e] = (float)cos((double)ang); ((float*)(ws + WS_ROPE))[SEQ * 8 + e] = (float)sin((double)ang);
        }
        for (int e = bx * 512 + tid; e < BATCH * D / 2; e += G * 512) { const int b = e / (D / 2), c = e % (D / 2); ((unsigned*)(XN + (size_t)b * (SEQ + 1) * D))[c] = 0u; }
        norm_rows(args.in[I_X], args.in[I_NORMG], XN, gw, NGW, lane);
    PH_END

    for (int layer = 0; layer < 4; ++layer) {
        const int j = layer >> 1;
        const float* ng = args.in[I_NORMG] + (size_t)layer * 4 * D;
        const float* xin = (layer == 0) ? args.in[I_X] : X;
        if ((layer & 1) == 0) {
            PH_BEGIN
                pg8::Gemm g{XN, (const bf16_t*)(ws + WS_WBIG), M, NBIG, KBIG, D, KBIG, 2, 1 << 30, 0};
                epi::BigOut E{ws, layer == 0 ? WS_VF : WS_V};
                run_gemm(lds, g, G, E);
            PH_END
            PH_BEGIN
                pg8::Gemm g{(const bf16_t*)(ws + WS_L1), (const bf16_t*)(ws + WS_WL2), M, NL2, KL2, LDL1, KL2, 0, 12, 256};
                epi::L2Out E{ws, (const float*)(ws + WS_BIAS4)};
                run_gemm(lds, g, G, E);
            PH_END
            PH_BEGIN
                ScanArgs s{(const bf16_t*)(ws + WS_R), (const bf16_t*)(ws + WS_K), (const bf16_t*)(ws + (layer == 0 ? WS_VF : WS_V)), (const bf16_t*)(ws + WS_VF), (const bf16_t*)(ws + WS_LW),
                           (const bf16_t*)(ws + WS_AG), (const bf16_t*)(ws + WS_GG), (const bf16_t*)(ws + WS_VG), (bf16_t*)(ws + WS_YG),
                           args.in[I_KK] + j * D, args.in[I_KA] + j * D, args.in[I_RK] + j * D, args.in[I_LNW] + j * D, args.in[I_LNB] + j * D, layer == 2 ? 1 : 0};
#ifndef DIS_SCAN
                scan_v1(s, lds, bx, G);
#endif
                if (layer == 2) { __syncthreads(); cvt_attn(args, 1, ws, scr, gw, NGW, lane); cvt_ffn(args, 3, ws, scr, gw, NGW, lane); }
            PH_END
            PH_BEGIN
                pg8::Gemm g{(const bf16_t*)(ws + WS_YG), (const bf16_t*)(ws + WS_WOR), M, D, D, D, D, 0, 1 << 30, 0};
                epi::Bf16Out E{(bf16_t*)(ws + WS_TMP), D, nullptr};
                run_gemm(lds, g, G, E);
            PH_END
        } else {
            PH_BEGIN
                pg8::Gemm g{XN, (const bf16_t*)(ws + WS_WQKV), M, NQKV, D, D, D, 1, 1 << 30, 0};
                epi::QkvOut E{ws, args.in[I_BQKV] + (size_t)j * NQKV, rope};
                run_gemm(lds, g, G, E);
            PH_END
            PH_BEGIN
#ifndef DIS_ATTN
                attn_v1((const bf16_t*)(ws + WS_Q), (const bf16_t*)(ws + WS_KA), (const bf16_t*)(ws + WS_VA), (bf16_t*)(ws + WS_O), args.in[I_SINK] + j * NH, gw, NGW, lane);
#endif
                if (layer == 1) { cvt_rwkv(args, 1, ws, scr, gw, NGW, lane); cvt_ffn(args, 2, ws, scr, gw, NGW, lane); }
            PH_END
            PH_BEGIN
                pg8::Gemm g{(const bf16_t*)(ws + WS_O), (const bf16_t*)(ws + WS_WOA), M, D, D, D, D, 0, 1 << 30, 0};
                epi::Bf16Out E{(bf16_t*)(ws + WS_TMP), D, args.in[I_BOA] + (size_t)j * D};
                run_gemm(lds, g, G, E);
            PH_END
        }
        PH_BEGIN
            resnorm_rows((const bf16_t*)(ws + WS_TMP), xin, X, ng + D, ng + 2 * D, (bf16_t*)(ws + WS_XN2), false, gw, NGW, lane);
        PH_END
        PH_BEGIN
            pg8::Gemm g{(const bf16_t*)(ws + WS_XN2), (const bf16_t*)(ws + ((layer & 1) ? WS_WGU_B : WS_WGU_A)), M, 2 * DFF, D, D, D, 0, 1 << 30, 0};
            epi::SwigluOut E{(bf16_t*)(ws + WS_H)};
            run_gemm(lds, g, G, E);
        PH_END
        PH_BEGIN
            pg8::Gemm g{(const bf16_t*)(ws + WS_H), (const bf16_t*)(ws + ((layer & 1) ? WS_WD_B : WS_WD_A)), M, D, DFF, DFF, DFF, 0, 1 << 30, 0};
            epi::Bf16Out E{(bf16_t*)(ws + WS_TMP), D, nullptr};
            run_gemm(lds, g, G, E);
        PH_END
        PH_BEGIN
            resnorm_rows((const bf16_t*)(ws + WS_TMP), X, X, ng + 3 * D, ng + 4 * D, layer < 3 ? XN : nullptr, true, gw, NGW, lane);
        PH_END
    }
#undef PH_BEGIN
#undef PH_END
}

constexpr int N_PHASES = 1 + 2 * 8 + 2 * 7;

extern "C" void kernel_launch(void* const* d_in, const int* in_sizes, int n_in, void* d_out, int out_size, void* d_ws, size_t ws_size, hipStream_t stream) {
    static int grid = 0;
    if (grid == 0) {
        if (n_in != 28 || out_size != M * D || ws_size < WS_END) { fprintf(stderr, "kernel_launch: unexpected shapes (n_in %d out %d ws %zu)\n", n_in, out_size, ws_size); grid = -1; return; }
        int dev = 0, cus = 0;
        if (hipGetDevice(&dev) != hipSuccess || hipDeviceGetAttribute(&cus, hipDeviceAttributeMultiprocessorCount, dev) != hipSuccess) { grid = -1; return; }
        if (hipFuncSetAttribute((const void*)fwd_kernel, hipFuncAttributeMaxDynamicSharedMemorySize, LDS_BYTES) != hipSuccess) { fprintf(stderr, "kernel_launch: hipFuncSetAttribute failed\n"); grid = -1; return; }
        int per_cu = 0;
        if (hipOccupancyMaxActiveBlocksPerMultiprocessor(&per_cu, (const void*)fwd_kernel, NWAVES * 64, LDS_BYTES) != hipSuccess || per_cu < 1) { fprintf(stderr, "kernel_launch: occupancy query says %d\n", per_cu); }
        (void)hipGetLastError();
        grid = cus;
    }
    if (grid < 0) return;
    if (hipMemsetAsync((char*)d_ws + WS_CTL, 0, CTL_ZERO_BYTES, stream) != hipSuccess) return;
    Args a{};
    for (int i = 0; i < 28; ++i) a.in[i] = (const float*)d_in[i];
    a.out = (float*)d_out; a.ws = (unsigned char*)d_ws;
#if MK_N_LAUNCHES == 1
    a.ph_lo = 0; a.ph_hi = N_PHASES;
    hipLaunchKernelGGL(fwd_kernel, dim3(grid), dim3(NWAVES * 64), LDS_BYTES, stream, a);
#else
    for (int p = 0; p < N_PHASES; ++p) { a.ph_lo = p; a.ph_hi = p + 1; hipLaunchKernelGGL(fwd_kernel, dim3(grid), dim3(NWAVES * 64), LDS_BYTES, stream, a); }
#endif
}
```

```cpp
#include <hip/hip_runtime.h>
#include <cstdio>
#include <cstdint>

#ifndef MK_N_LAUNCHES
#define MK_N_LAUNCHES 1
#endif
#ifndef USE_PG8
#define USE_PG8 1
#endif

#define LAS __attribute__((address_space(3)))
#define GAS __attribute__((address_space(1)))
typedef unsigned short bf16_t;
typedef short bf16x8 __attribute__((ext_vector_type(8)));
typedef float f32x4 __attribute__((ext_vector_type(4)));
typedef float f32x16 __attribute__((ext_vector_type(16)));
typedef unsigned u32x4 __attribute__((ext_vector_type(4)));
typedef unsigned u32x2 __attribute__((ext_vector_type(2)));

constexpr int BATCH = 8, SEQ = 2048, D = 1024, M = BATCH * SEQ, DFF = 2816, NH = 16, HD = 64, NKV = 4;
constexpr int NBIG = 3584;
constexpr int KBIG = 2048;
constexpr int NL2 = 4096, KL2 = 256, LDL1 = 512;
constexpr int NQKV = 1536;
constexpr float RMS_EPS = 1e-6f, GN_EPS = 64e-5f;
constexpr float LOG2E = 1.4426950408889634f;
constexpr float QSCALE = 0.125f * LOG2E;

constexpr size_t MiB = 1u << 20;
constexpr size_t WS_CTL = 0, CTL_ZERO_BYTES = 1 * MiB;
constexpr size_t WS_ROPE = 1 * MiB;
constexpr size_t WS_BIAS4 = 1 * MiB + 512 * 1024;
constexpr size_t WS_WBIG = 2 * MiB, WS_WL2 = 16 * MiB, WS_WOR = 18 * MiB;
constexpr size_t WS_WQKV = 20 * MiB, WS_WOA = 23 * MiB;
constexpr size_t WS_WGU_A = 25 * MiB, WS_WD_A = 36 * MiB;
constexpr size_t WS_WGU_B = 42 * MiB, WS_WD_B = 53 * MiB;
constexpr size_t WS_XCH = 59 * MiB;
constexpr size_t WS_XN = 64 * MiB;
constexpr size_t WS_R = 97 * MiB, WS_K = 129 * MiB, WS_V = 161 * MiB, WS_VF = 193 * MiB, WS_AG = 225 * MiB, WS_GG = 257 * MiB, WS_VG = 289 * MiB, WS_L1 = 321 * MiB, WS_END = 337 * MiB;
constexpr size_t WS_LW = WS_XN, WS_YG = WS_R, WS_XN2 = WS_K, WS_TMP = WS_V, WS_H = WS_AG;
constexpr size_t WS_Q = WS_R, WS_KA = WS_K, WS_VA = WS_K + 8 * MiB, WS_O = WS_AG;
static_assert(WS_WBIG + (size_t)NBIG * KBIG * 2 <= WS_WL2 && WS_WL2 + (size_t)NL2 * KL2 * 2 <= WS_WOR && WS_WOR + (size_t)D * D * 2 <= WS_WQKV, "ws map 1");
static_assert(WS_WQKV + (size_t)NQKV * D * 2 <= WS_WOA && WS_WOA + (size_t)D * D * 2 <= WS_WGU_A, "ws map 2");
static_assert(WS_WGU_A + (size_t)2 * DFF * D * 2 <= WS_WD_A && WS_WD_A + (size_t)D * DFF * 2 <= WS_WGU_B && WS_WGU_B + (size_t)2 * DFF * D * 2 <= WS_WD_B && WS_WD_B + (size_t)D * DFF * 2 <= WS_XCH, "ws map 3");
static_assert(WS_XN + (size_t)(BATCH * (SEQ + 1)) * D * 2 <= WS_R && WS_H + (size_t)M * DFF * 2 <= WS_L1, "ws map 4");

constexpr int CW_TMO = 0, CW_CODE = 1, CW_BAR = 4096;

#define LDS_WAIT() asm volatile("s_waitcnt lgkmcnt(0)" ::: "memory")
#define VM_WAIT() asm volatile("s_waitcnt vmcnt(0)" ::: "memory")
#define RLX_AGENT __ATOMIC_RELAXED, __HIP_MEMORY_SCOPE_AGENT
__device__ __forceinline__ unsigned f2bf(float f) { unsigned u = __builtin_bit_cast(unsigned, f); return (u + 0x7fffu + ((u >> 16) & 1u)) >> 16; }
__device__ __forceinline__ unsigned pk2(float lo, float hi) { return f2bf(lo) | (f2bf(hi) << 16); }
__device__ __forceinline__ float bf2f(unsigned short b) { return __builtin_bit_cast(float, (unsigned)b << 16); }
__device__ __forceinline__ float bflo(unsigned w) { return __builtin_bit_cast(float, w << 16); }
__device__ __forceinline__ float bfhi(unsigned w) { return __builtin_bit_cast(float, w & 0xffff0000u); }
__device__ __forceinline__ float sigmoidf_(float x) { return 1.0f / (1.0f + __expf(-x)); }
__device__ __forceinline__ int lane_id() { int l; asm volatile("v_mbcnt_lo_u32_b32 %0, -1, 0\n\tv_mbcnt_hi_u32_b32 %0, -1, %0" : "=v"(l)); return l; }
__device__ __forceinline__ float tanh_fast(float x) { const float e = __expf(2.0f * fminf(fmaxf(x, -15.f), 15.f)); return (e - 1.0f) / (e + 1.0f); }
__device__ __forceinline__ float logdecay(float u) { const float z = -u; const float sp = fmaxf(z, 0.f) + __logf(1.0f + __expf(-fabsf(z))); return -__expf(-sp - 0.5f); }
__device__ __forceinline__ float wave_sum(float v) {
#pragma unroll
    for (int o = 1; o < 64; o <<= 1) v += __shfl_xor(v, o);
    return v;
}
__device__ __forceinline__ float sum8(float v) { v += __shfl_xor(v, 1); v += __shfl_xor(v, 2); v += __shfl_xor(v, 4); return v; }
__device__ __forceinline__ void unpack8(const u32x4 w, float (&o)[8]) { o[0] = bflo(w.x); o[1] = bfhi(w.x); o[2] = bflo(w.y); o[3] = bfhi(w.y); o[4] = bflo(w.z); o[5] = bfhi(w.z); o[6] = bflo(w.w); o[7] = bfhi(w.w); }

namespace pg8 {
constexpr int BM = 256, BK = 64, HALF = 128, HTB = HALF * BK * 2, STAGE_BYTES = 8 * HTB, NXCD = 8, WGM = 8;
__host__ __device__ __forceinline__ int lds_byte(int r, int c) { const int st = (r >> 4) * 2 + (c >> 5), rr = r & 15, cc = c & 31, ob = rr * 64 + cc * 2; return st * 1024 + (ob ^ (((ob >> 9) & 1) << 5)); }
__host__ __device__ __forceinline__ void stage_rc(int b, int& R, int& C) { const int st = b / 1024, sb = b % 1024, swz = sb ^ (((sb >> 9) & 1) << 5); R = (st >> 1) * 16 + swz / 64; C = (st & 1) * 32 + (swz % 64) / 2; }
__host__ __device__ __forceinline__ int perm32(int rho) { const int n = rho >> 4, i = rho & 15; return 8 * (i >> 2) + 4 * n + (i & 3); }

struct Unit { int pm, pn; };
struct Gemm {
    const bf16_t* A; const bf16_t* Bt; int M, N, K, lda, ldb;
    int a_mode;
    int a_coltile, a_coloff;
    __device__ __forceinline__ const char* a_ptr(int pm, int pn) const {
        const size_t row = (size_t)pm * 256 + (a_mode == 0 ? 0 : (pm >> 3) + (a_mode == 1 ? 1 : 0));
        return (const char*)(A + row * lda + (pn >= a_coltile ? a_coloff : 0));
    }
    __device__ __forceinline__ const char* b_ptr(int pn) const { return (const char*)(Bt + (size_t)pn * 256 * ldb); }
};
struct StaticOrder {
    int nM, nN, nwg, G, c;
    __host__ __device__ void init(int M_, int N_, int G_, int c_) { nM = M_ / BM; nN = N_ / BM; nwg = nM * nN; G = G_; c = c_; }
    __host__ __device__ bool next(int i, Unit& u) const {
        const long L = (long)i * G + c; if (L >= nwg) return false;
        int wgid = (int)L; { const int q = nwg / NXCD, r = nwg % NXCD, xcd = wgid % NXCD, off = wgid / NXCD; wgid = (xcd < r ? xcd * (q + 1) : r * (q + 1) + (xcd - r) * q) + off; }
        const int nig = WGM * nN, gid = wgid / nig, fm = gid * WGM, gsz = (nM - fm) < WGM ? (nM - fm) : WGM;
        u.pm = fm + ((wgid % nig) % gsz); u.pn = (wgid % nig) / gsz; return true;
    }
};

template <class Epi>
__device__ __forceinline__ void gemm_simple(const Gemm g, int G, int c, const Epi& E, int tid) {
    const int wid = __builtin_amdgcn_readfirstlane(tid >> 6), lane = tid & 63, wr = wid >> 2, wc = wid & 3, fr = lane & 15, fq = lane >> 4;
    StaticOrder S; S.init(g.M, g.N, G, c);
    Unit u;
    for (int i = 0; S.next(i, u); ++i) {
        f32x4 acc[2][2][4][2];
#pragma unroll
        for (int a = 0; a < 2; ++a)
#pragma unroll
            for (int b = 0; b < 2; ++b)
#pragma unroll
                for (int m = 0; m < 4; ++m)
#pragma unroll
                    for (int n = 0; n < 2; ++n) acc[a][b][m][n] = (f32x4){0.f, 0.f, 0.f, 0.f};
        const char* Ab = g.a_ptr(u.pm, u.pn);
        const char* Bb = g.b_ptr(u.pn);
        const unsigned aoff = (unsigned)((wr * 64 + fr) * g.lda + fq * 8) * 2u;
        unsigned boff[2];
#pragma unroll
        for (int n = 0; n < 2; ++n) { const int rho = 16 * n + fr; boff[n] = (unsigned)((wc * 32 + (Epi::PERM ? perm32(rho) : rho)) * g.ldb + fq * 8) * 2u; }
        const unsigned a16 = (unsigned)(16 * g.lda) * 2u, a128 = 8u * a16, b128 = (unsigned)(128 * g.ldb) * 2u;
#pragma unroll 1
        for (int k0 = 0; k0 < g.K; k0 += 32) {
            bf16x8 b[2][2];
#pragma unroll
            for (int bj = 0; bj < 2; ++bj)
#pragma unroll
                for (int n = 0; n < 2; ++n) b[bj][n] = *(const bf16x8*)(Bb + (boff[n] + bj * b128 + (unsigned)k0 * 2u));
#pragma unroll
            for (int ai = 0; ai < 2; ++ai) {
                bf16x8 a[4];
#pragma unroll
                for (int m = 0; m < 4; ++m) a[m] = *(const bf16x8*)(Ab + (aoff + ai * a128 + m * a16 + (unsigned)k0 * 2u));
#pragma unroll
                for (int bj = 0; bj < 2; ++bj)
#pragma unroll
                    for (int m = 0; m < 4; ++m)
#pragma unroll
                        for (int n = 0; n < 2; ++n) acc[ai][bj][m][n] = __builtin_amdgcn_mfma_f32_16x16x32_bf16(b[bj][n], a[m], acc[ai][bj][m][n], 0, 0, 0);
            }
        }
        asm volatile("" ::: "memory");
        E(acc, u, wr, wc, fr, fq);
    }
}
template <class Epi, bool ALIGN_EPI = false, bool SP2 = false>
__device__ __forceinline__ void gemm_phase(LAS unsigned char* lds, const Gemm g, const StaticOrder& S, const Epi& E, int tid) {
    const int wid = __builtin_amdgcn_readfirstlane(tid >> 6), lane = tid & 63, wr = wid >> 2, wc = wid & 3, fr = lane & 15, fq = lane >> 4;
    const int K = g.K, nt = K / BK;
    unsigned voffA[2], voffB[2];
#pragma unroll
    for (int i = 0; i < 2; ++i) { int R, C; stage_rc(tid * 16 + i * 8192, R, C); const int Rb = Epi::PERM ? ((R & ~31) + perm32(R & 31)) : R;
        voffA[i] = (unsigned)(R * g.lda + C) * 2u; voffB[i] = (unsigned)(Rb * g.ldb + C) * 2u; }
    const size_t kstep = (size_t)(BK * 2);
    const size_t hstepA = (size_t)HALF * g.lda * 2, hstepB = (size_t)HALF * g.ldb * 2;
    const unsigned ldsw = (unsigned)wid * 1024u;
    const int aoff = lds_byte(wr * 64 + fr, fq * 8), boff = lds_byte(wc * 32 + fr, fq * 8);
#define PG8_SA(b, h) (((b) * 2 + (h)) * HTB)
#define PG8_SB(b, h) ((4 + (b) * 2 + (h)) * HTB)
#define PG8_STAGE(bufoff, gbase, voff) do { _Pragma("unroll") for (int _i = 0; _i < 2; ++_i) \
        __builtin_amdgcn_global_load_lds((const unsigned*)((const char*)(gbase) + (voff)[_i]), (LAS unsigned*)(lds + (bufoff) + ldsw + _i * 8192), 16, 0, 0); } while (0)
#define PG8_LDA(dst, b, h) do { _Pragma("unroll") for (int m = 0; m < 4; ++m) _Pragma("unroll") for (int k = 0; k < 2; ++k) dst[m][k] = *(const LAS bf16x8*)(lds + PG8_SA(b, h) + aoff + m * 2048 + k * 1024); } while (0)
#define PG8_LDB(dst, b, h) do { _Pragma("unroll") for (int n = 0; n < 2; ++n) _Pragma("unroll") for (int k = 0; k < 2; ++k) dst[n][k] = *(const LAS bf16x8*)(lds + PG8_SB(b, h) + boff + n * 2048 + k * 1024); } while (0)
#define PG8_MMA(ai, bj, At, Bt) do { __builtin_amdgcn_s_setprio(1); _Pragma("unroll") for (int m = 0; m < 4; ++m) _Pragma("unroll") for (int n = 0; n < 2; ++n) _Pragma("unroll") for (int k = 0; k < 2; ++k) \
        acc[ai][bj][m][n] = __builtin_amdgcn_mfma_f32_16x16x32_bf16(Bt[n][k], At[m][k], acc[ai][bj][m][n], 0, 0, 0); __builtin_amdgcn_s_setprio(0); } while (0)
#define PG8_WAIT_V(n) asm volatile("s_waitcnt vmcnt(" #n ")" ::: "memory")
#define PG8_WAIT_L(n) asm volatile("s_waitcnt lgkmcnt(" #n ")" ::: "memory")
#define PG8_BAR __builtin_amdgcn_s_barrier()
#define PG8_SCHED __builtin_amdgcn_sched_barrier(0)
    Unit cur, nxt; int ui = 0;
    if (!S.next(0, cur)) return;
    f32x4 acc[2][2][4][2];
#pragma unroll
    for (int a = 0; a < 2; ++a)
#pragma unroll
        for (int b = 0; b < 2; ++b)
#pragma unroll
            for (int m = 0; m < 4; ++m)
#pragma unroll
                for (int n = 0; n < 2; ++n) acc[a][b][m][n] = (f32x4){0.f, 0.f, 0.f, 0.f};
    bf16x8 At[4][2], B0[2][2], B1[2][2];
    const char* cA = g.a_ptr(cur.pm, cur.pn); const char* cB = g.b_ptr(cur.pn);
    if constexpr (SP2) {
        PG8_STAGE(PG8_SB(0, 0), cB, voffB); PG8_STAGE(PG8_SB(0, 1), cB + hstepB, voffB); PG8_STAGE(PG8_SA(0, 0), cA, voffA); PG8_STAGE(PG8_SA(0, 1), cA + hstepA, voffA);
        if (wr == 1) PG8_BAR;
        PG8_WAIT_V(2); PG8_BAR;
        PG8_STAGE(PG8_SB(1, 0), cB + kstep, voffB); PG8_STAGE(PG8_SA(1, 0), cA + kstep, voffA); PG8_STAGE(PG8_SB(1, 1), cB + hstepB + kstep, voffB);
        PG8_WAIT_V(6); PG8_BAR;
    } else {
        PG8_STAGE(PG8_SB(0, 0), cB, voffB); PG8_STAGE(PG8_SA(0, 0), cA, voffA); PG8_STAGE(PG8_SB(0, 1), cB + hstepB, voffB); PG8_STAGE(PG8_SA(0, 1), cA + hstepA, voffA);
        if (wr == 1) PG8_BAR;
        PG8_WAIT_V(4); PG8_BAR;
        PG8_STAGE(PG8_SB(1, 0), cB + kstep, voffB); PG8_STAGE(PG8_SA(1, 0), cA + kstep, voffA); PG8_STAGE(PG8_SB(1, 1), cB + hstepB + kstep, voffB);
        PG8_WAIT_V(6); PG8_BAR;
    }
    for (;;) {
        const bool has_next = S.next(ui + 1, nxt);
        const char* nA = has_next ? g.a_ptr(nxt.pm, nxt.pn) : cA; const char* nB = has_next ? g.b_ptr(nxt.pn) : cB;
        for (int t = 0; t < nt; t += 2) {
            const bool last = (t == nt - 2);
            const char* a1 = cA + (size_t)(t + 1) * kstep;
            const char* a2 = last ? nA : cA + (size_t)(t + 2) * kstep; const char* b2 = last ? nB : cB + (size_t)(t + 2) * kstep;
            const char* a3 = a2 + kstep; const char* b3 = b2 + kstep;
            if constexpr (SP2) {
            PG8_LDB(B0, 0, 0); PG8_LDB(B1, 0, 1); PG8_SCHED; PG8_LDA(At, 0, 0); PG8_STAGE(PG8_SA(1, 1), a1 + hstepA, voffA);
            PG8_WAIT_V(8); PG8_WAIT_L(0); PG8_BAR; PG8_MMA(0, 0, At, B0); PG8_MMA(0, 1, At, B1); PG8_BAR; PG8_SCHED;
            PG8_LDA(At, 0, 1); PG8_STAGE(PG8_SB(0, 0), b2, voffB); PG8_STAGE(PG8_SB(0, 1), b2 + hstepB, voffB); PG8_STAGE(PG8_SA(0, 0), a2, voffA);
            PG8_WAIT_V(8); PG8_WAIT_L(0); PG8_BAR; PG8_MMA(1, 0, At, B0); PG8_MMA(1, 1, At, B1); PG8_BAR; PG8_SCHED;
            PG8_LDB(B0, 1, 0); PG8_LDB(B1, 1, 1); PG8_SCHED; PG8_LDA(At, 1, 0); PG8_STAGE(PG8_SA(0, 1), a2 + hstepA, voffA);
            PG8_WAIT_V(8); PG8_WAIT_L(0); PG8_BAR; PG8_MMA(0, 0, At, B0); PG8_MMA(0, 1, At, B1); PG8_BAR; PG8_SCHED;
            PG8_LDA(At, 1, 1); PG8_STAGE(PG8_SB(1, 0), b3, voffB); PG8_STAGE(PG8_SB(1, 1), b3 + hstepB, voffB); PG8_STAGE(PG8_SA(1, 0), a3, voffA);
            PG8_WAIT_V(8); PG8_WAIT_L(0); PG8_BAR; PG8_MMA(1, 0, At, B0); PG8_MMA(1, 1, At, B1); PG8_BAR; PG8_SCHED;
            } else {
            PG8_LDB(B0, 0, 0); PG8_SCHED; PG8_LDA(At, 0, 0); PG8_STAGE(PG8_SA(1, 1), a1 + hstepA, voffA);
            PG8_WAIT_L(8); PG8_BAR; PG8_WAIT_L(0); PG8_MMA(0, 0, At, B0); PG8_BAR; PG8_SCHED;
            PG8_LDB(B1, 0, 1); PG8_STAGE(PG8_SB(0, 0), b2, voffB);
            PG8_BAR; PG8_WAIT_L(0); PG8_MMA(0, 1, At, B1); PG8_BAR;
            PG8_LDA(At, 0, 1); PG8_STAGE(PG8_SA(0, 0), a2, voffA);
            PG8_BAR; PG8_WAIT_L(0); PG8_MMA(1, 0, At, B0); PG8_BAR; PG8_SCHED;
            PG8_STAGE(PG8_SB(0, 1), b2 + hstepB, voffB);
            PG8_WAIT_V(6); PG8_BAR; PG8_MMA(1, 1, At, B1); PG8_BAR;
            PG8_LDB(B0, 1, 0); PG8_SCHED; PG8_LDA(At, 1, 0); PG8_STAGE(PG8_SA(0, 1), a2 + hstepA, voffA);
            PG8_WAIT_L(8); PG8_BAR; PG8_WAIT_L(0); PG8_MMA(0, 0, At, B0); PG8_BAR; PG8_SCHED;
            PG8_LDB(B1, 1, 1); PG8_STAGE(PG8_SB(1, 0), b3, voffB);
            PG8_BAR; PG8_WAIT_L(0); PG8_MMA(0, 1, At, B1); PG8_BAR;
            PG8_LDA(At, 1, 1); PG8_STAGE(PG8_SA(1, 0), a3, voffA);
            PG8_BAR; PG8_WAIT_L(0); PG8_MMA(1, 0, At, B0); PG8_BAR; PG8_SCHED;
            PG8_STAGE(PG8_SB(1, 1), b3 + hstepB, voffB);
            PG8_WAIT_V(6); PG8_BAR; PG8_MMA(1, 1, At, B1); PG8_BAR;
            }
        }
        if constexpr (ALIGN_EPI) { if (wr == 0) PG8_BAR; }
        if constexpr (!Epi::AFTER_DRAIN) { E(acc, cur, wr, wc, fr, fq); }
        if (!has_next) break;
#pragma unroll
        for (int a = 0; a < 2; ++a)
#pragma unroll
            for (int b = 0; b < 2; ++b)
#pragma unroll
                for (int m = 0; m < 4; ++m)
#pragma unroll
                    for (int n = 0; n < 2; ++n) acc[a][b][m][n] = (f32x4){0.f, 0.f, 0.f, 0.f};
        cur = nxt; cA = nA; cB = nB; ++ui;
        if constexpr (ALIGN_EPI) { if (wr == 1) PG8_BAR; }
    }
    PG8_WAIT_V(0);
    if constexpr (!ALIGN_EPI) { if (wr == 0) PG8_BAR; }
    PG8_BAR;
    if constexpr (Epi::AFTER_DRAIN) { E.fused(acc, cur, wr, wc, fr, fq, lds, wid, lane); }
#undef PG8_SA
#undef PG8_SB
#undef PG8_STAGE
#undef PG8_LDA
#undef PG8_LDB
#undef PG8_MMA
#undef PG8_WAIT_V
#undef PG8_WAIT_L
#undef PG8_BAR
#undef PG8_SCHED
}
}

namespace epi {
using pg8::Unit; using pg8::BM; using pg8::HALF;
__device__ __forceinline__ u32x4 pack8(const f32x4 v0, const f32x4 v1) { u32x4 w; w.x = pk2(v0[0], v0[1]); w.y = pk2(v0[2], v0[3]); w.z = pk2(v1[0], v1[1]); w.w = pk2(v1[2], v1[3]); return w; }

struct Bf16Out {
    static constexpr bool PERM = true, AFTER_DRAIN = false;
    bf16_t* O; int ldc; const float* bias;
    __device__ __forceinline__ void operator()(const f32x4 (&acc)[2][2][4][2], const Unit& u, int wr, int wc, int fr, int fq) const {
        const int row0 = u.pm * BM + wr * 64 + fr, col0 = u.pn * BM + wc * 32 + 8 * fq;
#pragma unroll
        for (int bj = 0; bj < 2; ++bj) {
            f32x4 b0 = (f32x4){0.f, 0.f, 0.f, 0.f}, b1 = b0;
            if (bias) { b0 = *(const f32x4*)(bias + col0 + bj * HALF); b1 = *(const f32x4*)(bias + col0 + bj * HALF + 4); }
#pragma unroll
            for (int ai = 0; ai < 2; ++ai)
#pragma unroll
                for (int m = 0; m < 4; ++m) {
                    bf16_t* p = O + (size_t)(row0 + ai * HALF + m * 16) * ldc + col0 + bj * HALF;
                    *(u32x4*)p = pack8(acc[ai][bj][m][0] + b0, acc[ai][bj][m][1] + b1);
                }
        }
    }
};

struct BigOut {
    static constexpr bool PERM = true, AFTER_DRAIN = false;
    unsigned char* ws; size_t v_off;
    __device__ __forceinline__ void operator()(const f32x4 (&acc)[2][2][4][2], const Unit& u, int wr, int wc, int fr, int fq) const {
        const int row0 = u.pm * BM + wr * 64 + fr;
        const int grp = u.pn >> 2;
        size_t boff = WS_R + (size_t)grp * (32 * MiB); if (grp == 2) boff = v_off; if (grp == 3) boff = WS_L1;
        bf16_t* base = (bf16_t*)(ws + boff);
        const int ldc = (grp == 3) ? LDL1 : D, colt = (grp == 3) ? (u.pn - 12) * BM : (u.pn & 3) * BM;
        int act0 = 0, act1 = 0;
        if (u.pn == 12) { act0 = (wc < 2) ? 1 : 0; act1 = 2; }
        const int col0 = colt + wc * 32 + 8 * fq;
#pragma unroll
        for (int bj = 0; bj < 2; ++bj) {
            const int act = bj ? act1 : act0;
#pragma unroll
            for (int ai = 0; ai < 2; ++ai)
#pragma unroll
                for (int m = 0; m < 4; ++m) {
                    f32x4 v0 = acc[ai][bj][m][0], v1 = acc[ai][bj][m][1];
                    if (act == 1) {
#pragma unroll
                        for (int j = 0; j < 4; ++j) { v0[j] = tanh_fast(v0[j]); v1[j] = tanh_fast(v1[j]); }
                    } else if (act == 2) {
#pragma unroll
                        for (int j = 0; j < 4; ++j) { v0[j] = sigmoidf_(v0[j]); v1[j] = sigmoidf_(v1[j]); }
                    }
                    *(u32x4*)(base + (size_t)(row0 + ai * HALF + m * 16) * ldc + col0 + bj * HALF) = pack8(v0, v1);
                }
        }
    }
};

struct L2Out {
    static constexpr bool PERM = true, AFTER_DRAIN = false;
    unsigned char* ws; const float* bias4;
    __device__ __forceinline__ void operator()(const f32x4 (&acc)[2][2][4][2], const Unit& u, int wr, int wc, int fr, int fq) const {
        const int row0 = u.pm * BM + wr * 64 + fr, grp = u.pn >> 2, col0 = (u.pn & 3) * BM + wc * 32 + 8 * fq;
        bf16_t* base = (bf16_t*)(ws + (grp == 0 ? WS_LW : WS_AG + (size_t)(grp - 1) * (32 * MiB)));
        const float* bias = bias4 + grp * D;
#pragma unroll
        for (int bj = 0; bj < 2; ++bj) {
            const f32x4 b0 = *(const f32x4*)(bias + col0 + bj * HALF), b1 = *(const f32x4*)(bias + col0 + bj * HALF + 4);
#pragma unroll
            for (int ai = 0; ai < 2; ++ai)
#pragma unroll
                for (int m = 0; m < 4; ++m) {
                    f32x4 v0_ = acc[ai][bj][m][0] + b0, v1_ = acc[ai][bj][m][1] + b1;
                    if (grp == 0) {
#pragma unroll
                        for (int j = 0; j < 4; ++j) { v0_[j] = logdecay(v0_[j]); v1_[j] = logdecay(v1_[j]); }
                    } else if (grp != 2) {
#pragma unroll
                        for (int j = 0; j < 4; ++j) { v0_[j] = sigmoidf_(v0_[j]); v1_[j] = sigmoidf_(v1_[j]); }
                    }
                    *(u32x4*)(base + (size_t)(row0 + ai * HALF + m * 16) * D + col0 + bj * HALF) = pack8(v0_, v1_);
                }
        }
    }
};

struct QkvOut {
    static constexpr bool PERM = true, AFTER_DRAIN = false;
    unsigned char* ws; const float* bias; const float* rope;
    __device__ __forceinline__ void operator()(const f32x4 (&acc)[2][2][4][2], const Unit& u, int wr, int wc, int fr, int fq) const {
        const int row0 = u.pm * BM + wr * 64 + fr;
        const bool isq = u.pn < 4;
        bf16_t* base = (bf16_t*)(ws + (isq ? WS_Q : WS_KA + (size_t)(u.pn - 4) * (8 * MiB)));
        const int ldc = isq ? D : 256, colt = isq ? u.pn * BM : 0; const float sc = isq ? QSCALE : 1.f;
        const bool rot = (u.pn < 5) && ((wc & 1) == 0) && (fq < 2);
#pragma unroll
        for (int bj = 0; bj < 2; ++bj) {
            const int cl = bj * HALF + wc * 32 + 8 * fq;
            const int scol = u.pn * BM + cl;
            float bv[8];
#pragma unroll
            for (int i = 0; i < 8; ++i) {
                const int dp = (scol + i) & 63; int d = dp;
                if (u.pn < 5 && dp < 16) d = (dp >> 1) + 8 * (dp & 1);
                bv[i] = bias[((scol + i) & ~63) + d];
            }
#pragma unroll
            for (int ai = 0; ai < 2; ++ai)
#pragma unroll
                for (int m = 0; m < 4; ++m) {
                    const int row = row0 + ai * HALF + m * 16;
                    float v[8];
#pragma unroll
                    for (int i = 0; i < 4; ++i) { v[i] = acc[ai][bj][m][0][i] + bv[i]; v[4 + i] = acc[ai][bj][m][1][i] + bv[4 + i]; }
                    if (rot) {
                        const int pos = row & (SEQ - 1);
                        const f32x4 cs = *(const f32x4*)(rope + pos * 8 + 4 * fq), sn = *(const f32x4*)(rope + SEQ * 8 + pos * 8 + 4 * fq);
#pragma unroll
                        for (int i = 0; i < 4; ++i) { const float x1 = v[2 * i], x2 = v[2 * i + 1]; v[2 * i] = x1 * cs[i] - x2 * sn[i]; v[2 * i + 1] = x2 * cs[i] + x1 * sn[i]; }
                    }
                    u32x4 w; w.x = pk2(v[0] * sc, v[1] * sc); w.y = pk2(v[2] * sc, v[3] * sc); w.z = pk2(v[4] * sc, v[5] * sc); w.w = pk2(v[6] * sc, v[7] * sc);
                    *(u32x4*)(base + (size_t)row * ldc + colt + cl) = w;
                }
        }
    }
};

struct SwigluOut {
    static constexpr bool PERM = true, AFTER_DRAIN = false;
    bf16_t* H;
    __device__ __forceinline__ void operator()(const f32x4 (&acc)[2][2][4][2], const Unit& u, int wr, int wc, int fr, int fq) const {
        const int row0 = u.pm * BM + wr * 64 + fr, col0 = u.pn * HALF + wc * 32 + 8 * fq;
#pragma unroll
        for (int ai = 0; ai < 2; ++ai)
#pragma unroll
            for (int m = 0; m < 4; ++m) {
                f32x4 o0, o1;
#pragma unroll
                for (int j = 0; j < 4; ++j) {
                    const float g0 = acc[ai][0][m][0][j], g1 = acc[ai][0][m][1][j];
                    o0[j] = g0 * sigmoidf_(g0) * acc[ai][1][m][0][j]; o1[j] = g1 * sigmoidf_(g1) * acc[ai][1][m][1][j];
                }
                *(u32x4*)(H + (size_t)(row0 + ai * HALF + m * 16) * DFF + col0) = pack8(o0, o1);
            }
    }
};
}

#define XB_TMO      128
#define XB_XCNT(j)  (256  + 64 * (j))
#define XB_XSUB(j)  (1280 + 64 * (j))
#define XB_XGEN(j)  (2304 + 64 * (j))
#define XB_TOP      3328
#define XB_TOPGEN   3392
#define XCD_BAR_WORDS 3456
#define XB_SPIN_CAP (1u << 22)
__device__ __forceinline__ unsigned xb_ld(unsigned* p)              { return __hip_atomic_load(p, __ATOMIC_RELAXED, __HIP_MEMORY_SCOPE_AGENT); }
__device__ __forceinline__ unsigned xb_add(unsigned* p, unsigned v) { return __hip_atomic_fetch_add(p, v, __ATOMIC_RELAXED, __HIP_MEMORY_SCOPE_AGENT); }
__device__ __forceinline__ unsigned xb_xcc_id() { return (unsigned)__builtin_amdgcn_s_getreg((3 << 11) | 20) & 0xFu; }
#define XB_SPIN(cond, bar) do { unsigned _sp = 0; while (cond) { __builtin_amdgcn_s_sleep(1); \
    if ((++_sp & 255u) == 0u) { if (xb_ld(&(bar)[XB_TMO])) break; if (_sp > XB_SPIN_CAP) { atomicAdd(&(bar)[XB_TMO], 1u); break; } } } } while (0)
struct XcdBarrier { unsigned* bar; unsigned x; volatile LAS unsigned* st; };
__device__ __forceinline__ XcdBarrier xcd_barrier_post(unsigned* bar, volatile LAS unsigned* st, bool leader) {
    XcdBarrier b; b.bar = bar; b.x = xb_xcc_id(); b.st = st;
    if (leader) (void)xb_add(&bar[XB_XCNT(b.x)], 1u);
    return b;
}
__device__ __forceinline__ void xcd_barrier_complete(unsigned* bar, unsigned x, unsigned& nloc, unsigned& nx) {
    const unsigned G = gridDim.x * gridDim.y * gridDim.z;
    unsigned sum, cnt, mine, sp = 0u;
    for (;;) {
        sum = 0u; cnt = 0u; mine = 0u;
#pragma unroll
        for (unsigned j = 0; j < 16; ++j) { const unsigned c = xb_ld(&bar[XB_XCNT(j)]); sum += c; cnt += (c > 0u) ? 1u : 0u; mine = (j == x) ? c : mine; }
        if (sum == G) break;
        __builtin_amdgcn_s_sleep(1);
        if ((++sp & 255u) == 0u) { if (xb_ld(&bar[XB_TMO])) break; if (sp > XB_SPIN_CAP) { atomicAdd(&bar[XB_TMO], 1u); break; } }
    }
    nloc = mine > 0u ? mine : 1u; nx = cnt > 0u ? cnt : 1u;
}
__device__ __forceinline__ void xcd_barrier(const XcdBarrier& b, bool leader) {
    asm volatile("s_waitcnt vmcnt(0)" ::: "memory");
    __syncthreads();
    if (leader) {
        unsigned* bar = b.bar;
        __builtin_amdgcn_s_waitcnt(0);
        unsigned nloc = b.st[0], nx = b.st[1];
        if (nloc == 0u) { xcd_barrier_complete(bar, b.x, nloc, nx); b.st[0] = nloc; b.st[1] = nx; }
        const unsigned old = xb_add(&bar[XB_XSUB(b.x)], 1u);
        const unsigned gen = old / nloc;
        if (old + 1u == (gen + 1u) * nloc) {
            __builtin_amdgcn_fence(__ATOMIC_RELEASE, "agent");
            asm volatile("s_waitcnt vmcnt(0)" ::: "memory");
            const unsigned og = xb_add(&bar[XB_TOP], 1u);
            const unsigned tg = og / nx;
            if (og + 1u == (tg + 1u) * nx) xb_add(&bar[XB_TOPGEN], 1u);
            else XB_SPIN(xb_ld(&bar[XB_TOPGEN]) == tg, bar);
            __builtin_amdgcn_fence(__ATOMIC_ACQUIRE, "agent");
            xb_add(&bar[XB_XGEN(b.x)], 1u);
            asm volatile("s_waitcnt vmcnt(0)" ::: "memory");
        } else {
            XB_SPIN(xb_ld(&bar[XB_XGEN(b.x)]) == gen, bar);
            __builtin_amdgcn_fence(__ATOMIC_ACQUIRE, "agent");
            asm volatile("s_waitcnt vmcnt(0)" ::: "memory");
        }
    }
    __syncthreads();
}

constexpr int RING_OFF = 0, RING_BYTES = 131072;
constexpr int LDSCTL_OFF = RING_BYTES, MISC_OFF = LDSCTL_OFF + 320;
constexpr int LDS_BYTES = 147456;
constexpr int NWAVES = 8;

struct Args { const float* in[28]; float* out; unsigned char* ws; int ph_lo, ph_hi; };
typedef const float* const __attribute__((address_space(4))) * InTab;
static_assert(offsetof(Args, out) == 224 && offsetof(Args, ws) == 232, "kernarg layout");
enum { I_X = 0, I_NORMG, I_XMIX, I_WRKV, I_W0, I_W1, I_W2, I_A0, I_A1, I_A2, I_V0, I_V1, I_V2, I_G1, I_G2, I_KK, I_KA, I_RK, I_LNW, I_LNB, I_WOR,
       I_WQKV, I_BQKV, I_SINK, I_WOA, I_BOA, I_WGU, I_WD };

template <class F>
__device__ __forceinline__ void cvt_matrix(bf16_t* WT, int N, int K, const F& f, LAS float* scr, int gw, int NGW, int lane) {
    const int nblk = N / 32, nitems = nblk * (K / 64);
    for (int it = gw; it < nitems; it += NGW) {
        const int kb = it / nblk, nb = it % nblk, k0 = 64 * kb, n0 = 32 * nb;
#pragma unroll 8
        for (int i = 0; i < 32; ++i) { const int kk = 2 * i + (lane >> 5); scr[kk * 33 + (lane & 31)] = f(n0 + (lane & 31), k0 + kk); }
        LDS_WAIT(); asm volatile("" ::: "memory");
        const int c = lane & 7;
#pragma unroll
        for (int j = 0; j < 4; ++j) { const int n = (lane >> 3) + 8 * j; const LAS float* s = scr + (8 * c) * 33 + n;
            u32x4 o; o.x = pk2(s[0 * 33], s[1 * 33]); o.y = pk2(s[2 * 33], s[3 * 33]); o.z = pk2(s[4 * 33], s[5 * 33]); o.w = pk2(s[6 * 33], s[7 * 33]);
            *(u32x4*)(WT + (size_t)(n0 + n) * K + k0 + 8 * c) = o; }
        LDS_WAIT(); asm volatile("" ::: "memory");
    }
}
struct FBig {
    const float *wrkv, *w1, *a1, *g1, *v1, *mix; int has_v;
    __device__ __forceinline__ float operator()(int n, int k) const {
        const int kk = k & 1023; float w; int mi;
        if (n < 3072) { mi = n >> 10; w = wrkv[((size_t)mi * D + kk) * D + (n & 1023)]; }
        else if (n < 3136) { mi = 3; w = w1[kk * 64 + (n - 3072)]; }
        else if (n < 3200) { mi = 4; w = a1[kk * 64 + (n - 3136)]; }
        else if (n < 3328) { mi = 5; w = g1[kk * 128 + (n - 3200)]; }
        else if (n < 3360 && has_v) { mi = 2; w = v1[kk * 32 + (n - 3328)]; }
        else return 0.f;
        const float mx = mix[mi * D + kk];
        return w * (k < 1024 ? mx : 1.0f - mx);
    }
};
struct FL2 {
    const float *w2, *a2, *g2, *v2; int has_v;
    __device__ __forceinline__ float operator()(int n, int k) const {
        const int grp = n >> 10, c = n & 1023;
        if (grp == 0) return k < 64 ? w2[k * D + c] : 0.f;
        if (grp == 1) return (k >= 64 && k < 128) ? a2[(k - 64) * D + c] : 0.f;
        if (grp == 2) return k >= 128 ? g2[(k - 128) * D + c] : 0.f;
        return (k < 32 && has_v) ? v2[k * D + c] : 0.f;
    }
};
struct FPlain { const float* W; int N;
    __device__ __forceinline__ float operator()(int n, int k) const { return W[(size_t)k * N + n]; } };
struct FQkv { const float* W;
    __device__ __forceinline__ float operator()(int n, int k) const { int sn = n; if (n < 1280) { const int dp = n & 63; if (dp < 16) sn = (n & ~63) + (dp >> 1) + 8 * (dp & 1); } return W[(size_t)k * NQKV + sn]; } };
struct FGu { const float* W;
    __device__ __forceinline__ float operator()(int n, int k) const { const int t = n >> 8, r = n & 255; const int sn = (r < 128) ? t * 128 + r : DFF + t * 128 + (r - 128); return W[(size_t)k * (2 * DFF) + sn]; } };

__device__ __forceinline__ void cvt_rwkv(InTab a, int j, unsigned char* ws, LAS float* scr, int gw, int NGW, int lane) {
    FBig fb{a[I_WRKV] + (size_t)j * 3 * D * D, a[I_W1] + (size_t)j * D * 64, a[I_A1] + (size_t)j * D * 64, a[I_G1] + (size_t)j * D * 128, a[I_V1], a[I_XMIX] + (size_t)j * 6 * D, j > 0 ? 1 : 0};
    cvt_matrix((bf16_t*)(ws + WS_WBIG), NBIG, KBIG, fb, scr, gw, NGW, lane);
    FL2 f2{a[I_W2] + (size_t)j * 64 * D, a[I_A2] + (size_t)j * 64 * D, a[I_G2] + (size_t)j * 128 * D, a[I_V2], j > 0 ? 1 : 0};
    cvt_matrix((bf16_t*)(ws + WS_WL2), NL2, KL2, f2, scr, gw, NGW, lane);
    FPlain fo{a[I_WOR] + (size_t)j * D * D, D};
    cvt_matrix((bf16_t*)(ws + WS_WOR), D, D, fo, scr, gw, NGW, lane);
    for (int e = gw * 64 + lane; e < 4 * D; e += NGW * 64) { const int grp = e >> 10, c = e & 1023; float v = 0.f;
        if (grp == 0) v = a[I_W0][j * D + c]; else if (grp == 1) v = a[I_A0][j * D + c]; else if (grp == 3) v = a[I_V0][c];
        ((float*)(ws + WS_BIAS4))[e] = v; }
}
__device__ __forceinline__ void cvt_attn(InTab a, int j, unsigned char* ws, LAS float* scr, int gw, int NGW, int lane) {
    FQkv fq{a[I_WQKV] + (size_t)j * D * NQKV};
    cvt_matrix((bf16_t*)(ws + WS_WQKV), NQKV, D, fq, scr, gw, NGW, lane);
    FPlain fo{a[I_WOA] + (size_t)j * D * D, D};
    cvt_matrix((bf16_t*)(ws + WS_WOA), D, D, fo, scr, gw, NGW, lane);
}
__device__ __forceinline__ void cvt_ffn(InTab a, int i, unsigned char* ws, LAS float* scr, int gw, int NGW, int lane) {
    const size_t ogu = (i & 1) ? WS_WGU_B : WS_WGU_A, od = (i & 1) ? WS_WD_B : WS_WD_A;
    FGu fg{a[I_WGU] + (size_t)i * D * 2 * DFF};
    cvt_matrix((bf16_t*)(ws + ogu), 2 * DFF, D, fg, scr, gw, NGW, lane);
    FPlain fd{a[I_WD] + (size_t)i * DFF * D, D};
    cvt_matrix((bf16_t*)(ws + od), D, DFF, fd, scr, gw, NGW, lane);
}

__device__ __forceinline__ size_t xn_row(int m) { return (size_t)m + (m >> 11) + 1; }
__device__ __forceinline__ void norm_rows(const float* x, const float* g, bf16_t* xn, int gw, int NGW, int lane) {
    f32x4 gv[4];
#pragma unroll
    for (int j = 0; j < 4; ++j) gv[j] = *((const f32x4*)g + lane + 64 * j);
    for (int m = gw; m < M; m += NGW) {
        const f32x4* xr = (const f32x4*)(x + (size_t)m * D) + lane;
        f32x4 v[4]; float s = 0.f;
#pragma unroll
        for (int j = 0; j < 4; ++j) { v[j] = xr[64 * j]; s += (v[j][0] * v[j][0] + v[j][1] * v[j][1]) + (v[j][2] * v[j][2] + v[j][3] * v[j][3]); }
        const float rstd = 1.0f / sqrtf(wave_sum(s) * (1.f / D) + RMS_EPS);
        u32x2* o = (u32x2*)(xn + xn_row(m) * D) + lane;
#pragma unroll
        for (int j = 0; j < 4; ++j) { u32x2 w; w.x = pk2(v[j][0] * rstd * gv[j][0], v[j][1] * rstd * gv[j][1]); w.y = pk2(v[j][2] * rstd * gv[j][2], v[j][3] * rstd * gv[j][3]); o[64 * j] = w; }
    }
}
__device__ __forceinline__ void resnorm_rows(const bf16_t* tmp, const float* xin, float* xout, const float* ga, const float* gb, bf16_t* xn, bool guard, int gw, int NGW, int lane) {
    for (int m = gw; m < M; m += NGW) {
        const u32x2* tr = (const u32x2*)(tmp + (size_t)m * D) + lane;
        const f32x4* xr = (const f32x4*)(xin + (size_t)m * D) + lane;
        f32x4 t[4], v[4]; float s = 0.f;
#pragma unroll
        for (int j = 0; j < 4; ++j) { const u32x2 w = tr[64 * j]; t[j] = (f32x4){bflo(w.x), bfhi(w.x), bflo(w.y), bfhi(w.y)}; v[j] = xr[64 * j];
            s += (t[j][0] * t[j][0] + t[j][1] * t[j][1]) + (t[j][2] * t[j][2] + t[j][3] * t[j][3]); }
        const float r1 = 1.0f / sqrtf(wave_sum(s) * (1.f / D) + RMS_EPS);
        float s2 = 0.f;
        f32x4* xo = (f32x4*)(xout + (size_t)m * D) + lane;
#pragma unroll
        for (int j = 0; j < 4; ++j) { const f32x4 gv = *((const f32x4*)ga + lane + 64 * j); v[j] = v[j] + t[j] * r1 * gv; xo[64 * j] = v[j];
            s2 += (v[j][0] * v[j][0] + v[j][1] * v[j][1]) + (v[j][2] * v[j][2] + v[j][3] * v[j][3]); }
        if (xn) {
            const float r2 = 1.0f / sqrtf(wave_sum(s2) * (1.f / D) + RMS_EPS);
            u32x2* o = (u32x2*)(xn + (guard ? xn_row(m) : (size_t)m) * D) + lane;
#pragma unroll
            for (int j = 0; j < 4; ++j) { const f32x4 gv = *((const f32x4*)gb + lane + 64 * j); u32x2 w; w.x = pk2(v[j][0] * r2 * gv[0], v[j][1] * r2 * gv[1]); w.y = pk2(v[j][2] * r2 * gv[2], v[j][3] * r2 * gv[3]); o[64 * j] = w; }
        }
    }
}

struct ScanArgs { const bf16_t *R, *K, *V, *VF, *LW, *AG, *GG, *VG; bf16_t* YG; const float *k_k, *k_a, *r_k, *lnw, *lnb; int layer2; };
__device__ __forceinline__ void scan_v1(const ScanArgs& s, LAS unsigned char* lds, int unit0, int ustride, int tid) {
    LAS float* Wd = (LAS float*)lds;
    LAS float* Aa = Wd + 4096;
    LAS float* Bb = Aa + 4096;
    LAS float* Kk = Bb + 4096;
    LAS float* Rr = Kk + 4096;
    LAS float* Vv = Rr + 4096;
    LAS float* Yy = Vv + 4096;
    LAS float* Bn = Yy + 4096;
    const int q8 = tid & 7, hi6 = tid >> 3;
    for (int unit = unit0; unit < BATCH * NH; unit += ustride) {
        const int b = unit >> 4, h = unit & 15, col = h * 64 + 8 * q8;
        float kkw[8], kaw[8], rkw[8], lw_[8], lb_[8];
#pragma unroll
        for (int i = 0; i < 8; ++i) { kkw[i] = s.k_k[col + i]; kaw[i] = s.k_a[col + i]; rkw[i] = s.r_k[col + i]; lw_[i] = s.lnw[col + i]; lb_[i] = s.lnb[col + i]; }
        float S[8];
#pragma unroll
        for (int i = 0; i < 8; ++i) S[i] = 0.f;
        for (int c = 0; c < SEQ / 64; ++c) {
            const size_t off = ((size_t)b * SEQ + c * 64 + hi6) * D + col;
            float gate[8];
            {
                float r[8], k[8], v[8], lw[8], ag[8];
                unpack8(*(const u32x4*)(s.R + off), r); unpack8(*(const u32x4*)(s.K + off), k); unpack8(*(const u32x4*)(s.V + off), v);
                unpack8(*(const u32x4*)(s.LW + off), lw); unpack8(*(const u32x4*)(s.AG + off), ag); unpack8(*(const u32x4*)(s.GG + off), gate);
                if (s.layer2) { float vf[8], vg[8]; unpack8(*(const u32x4*)(s.VF + off), vf); unpack8(*(const u32x4*)(s.VG + off), vg);
#pragma unroll
                    for (int i = 0; i < 8; ++i) v[i] = v[i] + (vf[i] - v[i]) * vg[i]; }
                float kk[8], ss = 0.f, bon = 0.f;
#pragma unroll
                for (int i = 0; i < 8; ++i) { kk[i] = k[i] * kkw[i]; ss += kk[i] * kk[i]; }
                ss = sum8(ss);
                const float inv = 1.0f / fmaxf(sqrtf(ss), 1e-12f);
#pragma unroll
                for (int i = 0; i < 8; ++i) {
                    kk[i] *= inv;
                    const float kp = k[i] * (1.0f + (ag[i] - 1.0f) * kaw[i]);
                    bon += r[i] * kp * rkw[i];
                    const int li = hi6 * 64 + 8 * q8 + i;
                    Wd[li] = __expf(lw[i]); Aa[li] = -kk[i]; Bb[li] = kk[i] * ag[i]; Kk[li] = kp; Rr[li] = r[i]; Vv[li] = v[i];
                }
                bon = sum8(bon);
                if (q8 == 0) Bn[hi6] = bon;
            }
            __syncthreads();
            for (int t = 0; t < 64; ++t) {
                const int li = t * 64 + 8 * q8;
                const f32x4 w0 = *(const LAS f32x4*)(Wd + li), w1 = *(const LAS f32x4*)(Wd + li + 4), a0 = *(const LAS f32x4*)(Aa + li), a1 = *(const LAS f32x4*)(Aa + li + 4);
                const f32x4 b0 = *(const LAS f32x4*)(Bb + li), b1 = *(const LAS f32x4*)(Bb + li + 4), k0 = *(const LAS f32x4*)(Kk + li), k1 = *(const LAS f32x4*)(Kk + li + 4);
                const f32x4 r0 = *(const LAS f32x4*)(Rr + li), r1 = *(const LAS f32x4*)(Rr + li + 4);
                const float vv = Vv[t * 64 + hi6];
                float sa = 0.f;
#pragma unroll
                for (int i = 0; i < 4; ++i) { sa += S[i] * a0[i]; sa += S[4 + i] * a1[i]; }
                sa = sum8(sa);
                float y = 0.f;
#pragma unroll
                for (int i = 0; i < 4; ++i) {
                    S[i] = S[i] * w0[i] + sa * b0[i] + vv * k0[i]; S[4 + i] = S[4 + i] * w1[i] + sa * b1[i] + vv * k1[i];
                    y += S[i] * r0[i]; y += S[4 + i] * r1[i];
                }
                y = sum8(y);
                if (q8 == 0) Yy[t * 64 + hi6] = y;
            }
            __syncthreads();
            {
                float y[8], mu = 0.f, var = 0.f;
#pragma unroll
                for (int i = 0; i < 8; ++i) { y[i] = Yy[hi6 * 64 + 8 * q8 + i]; mu += y[i]; }
                mu = sum8(mu) * (1.f / 64.f);
#pragma unroll
                for (int i = 0; i < 8; ++i) { y[i] -= mu; var += y[i] * y[i]; }
                var = sum8(var) * (1.f / 64.f);
                const float rs = 1.0f / sqrtf(var + GN_EPS), bon = Bn[hi6];
                float o[8];
#pragma unroll
                for (int i = 0; i < 8; ++i) o[i] = (y[i] * rs * lw_[i] + lb_[i] + bon * Vv[hi6 * 64 + 8 * q8 + i]) * gate[i];
                u32x4 w; w.x = pk2(o[0], o[1]); w.y = pk2(o[2], o[3]); w.z = pk2(o[4], o[5]); w.w = pk2(o[6], o[7]);
                *(u32x4*)(s.YG + off) = w;
            }
            __syncthreads();
        }
    }
}

__device__ __forceinline__ int crow(int r, int hi) { return (r & 3) + 8 * (r >> 2) + 4 * hi; }
__device__ __forceinline__ void attn_v1(const bf16_t* Q, const bf16_t* KA, const bf16_t* VA, bf16_t* O, const float* sinks, int gw, int NGW, int lane) {
    const int q = lane & 31, hi = lane >> 5;
    for (int unit = gw; unit < BATCH * NH * (SEQ / 32); unit += NGW) {
        const int qb = unit & 63, hq = (unit >> 6) & 15, b = unit >> 10, kvh = hq >> 2, t0 = qb * 32;
        const size_t rowb = (size_t)b * SEQ;
        bf16x8 qf[4];
#pragma unroll
        for (int ks = 0; ks < 4; ++ks) qf[ks] = *(const bf16x8*)(Q + (rowb + t0 + q) * D + hq * 64 + ks * 16 + hi * 8);
        f32x16 sc[5];
        float mx = sinks[hq] * LOG2E;
        const int qpos = t0 + q;
#pragma unroll
        for (int j = 0; j < 5; ++j) {
            const int kb = t0 - 128 + 32 * j; int kr = kb + q; kr = kr < 0 ? 0 : kr;
            f32x16 s = {};
#pragma unroll
            for (int ks = 0; ks < 4; ++ks) { const bf16x8 kf = *(const bf16x8*)(KA + (rowb + kr) * 256 + kvh * 64 + ks * 16 + hi * 8); s = __builtin_amdgcn_mfma_f32_32x32x16_bf16(kf, qf[ks], s, 0, 0, 0); }
#pragma unroll
            for (int r = 0; r < 16; ++r) { const int kpos = kb + crow(r, hi), rel = qpos - kpos; const bool ok = (kpos >= 0) && (rel >= 0) && (rel < 128); s[r] = ok ? s[r] : -INFINITY; mx = fmaxf(mx, s[r]); }
            sc[j] = s;
        }
        mx = fmaxf(mx, __shfl_xor(mx, 32));
        float l = 0.f;
#pragma unroll
        for (int j = 0; j < 5; ++j)
#pragma unroll
            for (int r = 0; r < 16; ++r) { const float p = exp2f(sc[j][r] - mx); sc[j][r] = p; l += p; }
        l += __shfl_xor(l, 32);
        l += exp2f(sinks[hq] * LOG2E - mx);
        f32x16 o[2]; o[0] = f32x16{}; o[1] = f32x16{};
#pragma unroll
        for (int j = 0; j < 5; ++j) {
            const int kb = t0 - 128 + 32 * j;
#pragma unroll
            for (int s2 = 0; s2 < 2; ++s2) {
                bf16x8 pf;
#pragma unroll
                for (int e = 0; e < 8; ++e) pf[e] = (short)f2bf(sc[j][8 * s2 + e]);
#pragma unroll
                for (int dt = 0; dt < 2; ++dt) {
                    bf16x8 vf;
#pragma unroll
                    for (int e = 0; e < 8; ++e) { int key = kb + 16 * s2 + 8 * (e >> 2) + 4 * hi + (e & 3); key = key < 0 ? 0 : key; vf[e] = (short)VA[(rowb + key) * 256 + kvh * 64 + dt * 32 + q]; }
                    o[dt] = __builtin_amdgcn_mfma_f32_32x32x16_bf16(vf, pf, o[dt], 0, 0, 0);
                }
            }
        }
        const float il = 1.0f / l;
#pragma unroll
        for (int dt = 0; dt < 2; ++dt)
#pragma unroll
            for (int g4 = 0; g4 < 4; ++g4) {
                const int d = dt * 32 + 8 * g4 + 4 * hi;
                u32x2 w; w.x = pk2(o[dt][4 * g4] * il, o[dt][4 * g4 + 1] * il); w.y = pk2(o[dt][4 * g4 + 2] * il, o[dt][4 * g4 + 3] * il);
                *(u32x2*)(O + (rowb + t0 + q) * D + hq * 64 + d) = w;
            }
    }
}

template <class Epi>
__device__ __forceinline__ void run_gemm(LAS unsigned char* lds, const pg8::Gemm& g, int G, const Epi& E, int tid) {
#if USE_PG8
    pg8::StaticOrder S; S.init(g.M, g.N, G, (int)blockIdx.x);
    pg8::gemm_phase<Epi, true, true>(lds + RING_OFF, g, S, E, tid);
#else
    pg8::gemm_simple<Epi>(g, G, (int)blockIdx.x, E, tid);
#endif
}

__global__ void __launch_bounds__(NWAVES * 64, 2) fwd_kernel(Args args) {
    extern __shared__ __attribute__((aligned(16))) unsigned char lds_raw[];
    LAS unsigned char* lds = (LAS unsigned char*)lds_raw;
    volatile LAS unsigned* MISC = (volatile LAS unsigned*)(lds + MISC_OFF);
    const int G = gridDim.x, bx = blockIdx.x;
    const int vcu = (G % 8 == 0) ? (bx % 8) * (G / 8) + bx / 8 : bx;
    const int NGW = G * NWAVES;
    unsigned char* const ws0 = args.ws;
    unsigned* ctl = (unsigned*)(ws0 + WS_CTL);
    const int wave0 = __builtin_amdgcn_readfirstlane((int)threadIdx.x >> 6);
    for (int u = wave0 * 64 + lane_id(); u < (LDS_BYTES - LDSCTL_OFF) / 4; u += NWAVES * 64) ((LAS unsigned*)(lds + LDSCTL_OFF))[u] = 0u;
    __syncthreads();
    XcdBarrier bar; bar.bar = ctl + CW_BAR; bar.x = 0; bar.st = nullptr;
    const int lo = args.ph_lo, hi = args.ph_hi;
    const bool multi = (hi - lo) > 1;
    if (multi) bar = xcd_barrier_post(ctl + CW_BAR, MISC + 8, wave0 == 0 && lane_id() == 0);
    int ph = 0;
#define PH_BEGIN if (ph >= lo && ph < hi) { int tid = wave0 * 64 + lane_id(); asm volatile("" : "+v"(tid)); \
        const __attribute__((address_space(4))) char* kp_ = (const __attribute__((address_space(4))) char*)__builtin_amdgcn_kernarg_segment_ptr(); asm volatile("" : "+s"(kp_)); \
        InTab in = (InTab)kp_; unsigned char* ws = *(unsigned char* const __attribute__((address_space(4)))*)(kp_ + 232); float* X = *(float* const __attribute__((address_space(4)))*)(kp_ + 224); (void)in; (void)ws; (void)X; \
        const float* rope = (const float*)(ws + WS_ROPE); bf16_t* XN = (bf16_t*)(ws + WS_XN); (void)rope; (void)XN; const int lane = tid & 63, wave = wave0; const int gw = vcu * NWAVES + wave; \
        LAS float* scr = (LAS float*)(lds + RING_OFF + wave * 16384); (void)lane; (void)gw; (void)scr;
#define PH_END } if (ph >= lo && ph + 1 < hi) xcd_barrier(bar, wave0 == 0 && lane_id() == 0); ++ph;


    PH_BEGIN
        cvt_rwkv(in, 0, ws, scr, gw, NGW, lane);
        cvt_ffn(in, 0, ws, scr, gw, NGW, lane);
        cvt_attn(in, 0, ws, scr, gw, NGW, lane);
        cvt_ffn(in, 1, ws, scr, gw, NGW, lane);
        for (int e = bx * 512 + tid; e < SEQ * 8; e += G * 512) {
            const int pos = e >> 3, i = e & 7;
            const float inv_freq = (float)exp2(-(double)i * 0.125 * 18.931568569324174);
            const float ang = (float)pos * inv_freq;
            ((float*)(ws + WS_ROPE))[e] = (float)cos((double)ang); ((float*)(ws + WS_ROPE))[SEQ * 8 + e] = (float)sin((double)ang);
        }
        for (int e = bx * 512 + tid; e < BATCH * D / 2; e += G * 512) { const int b = e / (D / 2), c = e % (D / 2); ((unsigned*)(XN + (size_t)b * (SEQ + 1) * D))[c] = 0u; }
        norm_rows(in[I_X], in[I_NORMG], XN, gw, NGW, lane);
    PH_END

    for (int layer = 0; layer < 4; ++layer) {
        const int j = layer >> 1;
        if ((layer & 1) == 0) {
            PH_BEGIN
                pg8::Gemm g{XN, (const bf16_t*)(ws + WS_WBIG), M, NBIG, KBIG, D, KBIG, 2, 1 << 30, 0};
                epi::BigOut E{ws, layer == 0 ? WS_VF : WS_V};
                run_gemm(lds, g, G, E, tid);
            PH_END
            PH_BEGIN
                pg8::Gemm g{(const bf16_t*)(ws + WS_L1), (const bf16_t*)(ws + WS_WL2), M, NL2, KL2, LDL1, KL2, 0, 12, 256};
                epi::L2Out E{ws, (const float*)(ws + WS_BIAS4)};
                run_gemm(lds, g, G, E, tid);
            PH_END
            PH_BEGIN
                ScanArgs s{(const bf16_t*)(ws + WS_R), (const bf16_t*)(ws + WS_K), (const bf16_t*)(ws + (layer == 0 ? WS_VF : WS_V)), (const bf16_t*)(ws + WS_VF), (const bf16_t*)(ws + WS_LW),
                           (const bf16_t*)(ws + WS_AG), (const bf16_t*)(ws + WS_GG), (const bf16_t*)(ws + WS_VG), (bf16_t*)(ws + WS_YG),
                           in[I_KK] + j * D, in[I_KA] + j * D, in[I_RK] + j * D, in[I_LNW] + j * D, in[I_LNB] + j * D, layer == 2 ? 1 : 0};
#ifndef DIS_SCAN
                scan_v1(s, lds, bx, G, tid);
#endif
                if (layer == 2) { __syncthreads(); cvt_attn(in, 1, ws, scr, gw, NGW, lane); cvt_ffn(in, 3, ws, scr, gw, NGW, lane); }
            PH_END
            PH_BEGIN
                pg8::Gemm g{(const bf16_t*)(ws + WS_YG), (const bf16_t*)(ws + WS_WOR), M, D, D, D, D, 0, 1 << 30, 0};
                epi::Bf16Out E{(bf16_t*)(ws + WS_TMP), D, nullptr};
                run_gemm(lds, g, G, E, tid);
            PH_END
        } else {
            PH_BEGIN
                pg8::Gemm g{XN, (const bf16_t*)(ws + WS_WQKV), M, NQKV, D, D, D, 1, 1 << 30, 0};
                epi::QkvOut E{ws, in[I_BQKV] + (size_t)j * NQKV, rope};
                run_gemm(lds, g, G, E, tid);
            PH_END
            PH_BEGIN
#ifndef DIS_ATTN
                attn_v1((const bf16_t*)(ws + WS_Q), (const bf16_t*)(ws + WS_KA), (const bf16_t*)(ws + WS_VA), (bf16_t*)(ws + WS_O), in[I_SINK] + j * NH, gw, NGW, lane);
#endif
                if (layer == 1) { cvt_rwkv(in, 1, ws, scr, gw, NGW, lane); cvt_ffn(in, 2, ws, scr, gw, NGW, lane); }
            PH_END
            PH_BEGIN
                pg8::Gemm g{(const bf16_t*)(ws + WS_O), (const bf16_t*)(ws + WS_WOA), M, D, D, D, D, 0, 1 << 30, 0};
                epi::Bf16Out E{(bf16_t*)(ws + WS_TMP), D, in[I_BOA] + (size_t)j * D};
                run_gemm(lds, g, G, E, tid);
            PH_END
        }
        PH_BEGIN
            const float* ng = in[I_NORMG] + (size_t)layer * 4 * D;
            resnorm_rows((const bf16_t*)(ws + WS_TMP), (layer == 0) ? in[I_X] : X, X, ng + D, ng + 2 * D, (bf16_t*)(ws + WS_XN2), false, gw, NGW, lane);
        PH_END
        PH_BEGIN
            pg8::Gemm g{(const bf16_t*)(ws + WS_XN2), (const bf16_t*)(ws + ((layer & 1) ? WS_WGU_B : WS_WGU_A)), M, 2 * DFF, D, D, D, 0, 1 << 30, 0};
            epi::SwigluOut E{(bf16_t*)(ws + WS_H)};
            run_gemm(lds, g, G, E, tid);
        PH_END
        PH_BEGIN
            pg8::Gemm g{(const bf16_t*)(ws + WS_H), (const bf16_t*)(ws + ((layer & 1) ? WS_WD_B : WS_WD_A)), M, D, DFF, DFF, DFF, 0, 1 << 30, 0};
            epi::Bf16Out E{(bf16_t*)(ws + WS_TMP), D, nullptr};
            run_gemm(lds, g, G, E, tid);
        PH_END
        PH_BEGIN
            const float* ng = in[I_NORMG] + (size_t)layer * 4 * D;
            resnorm_rows((const bf16_t*)(ws + WS_TMP), X, X, ng + 3 * D, ng + 4 * D, layer < 3 ? XN : nullptr, true, gw, NGW, lane);
        PH_END
    }
#undef PH_BEGIN
#undef PH_END
}

constexpr int N_PHASES = 1 + 2 * 8 + 2 * 7;

extern "C" void kernel_launch(void* const* d_in, const int* in_sizes, int n_in, void* d_out, int out_size, void* d_ws, size_t ws_size, hipStream_t stream) {
    static int grid = 0;
    if (grid == 0) {
        if (n_in != 28 || out_size != M * D || ws_size < WS_END) { fprintf(stderr, "kernel_launch: unexpected shapes (n_in %d out %d ws %zu)\n", n_in, out_size, ws_size); grid = -1; return; }
        int dev = 0, cus = 0;
        if (hipGetDevice(&dev) != hipSuccess || hipDeviceGetAttribute(&cus, hipDeviceAttributeMultiprocessorCount, dev) != hipSuccess) { grid = -1; return; }
        if (hipFuncSetAttribute((const void*)fwd_kernel, hipFuncAttributeMaxDynamicSharedMemorySize, LDS_BYTES) != hipSuccess) { fprintf(stderr, "kernel_launch: hipFuncSetAttribute failed\n"); grid = -1; return; }
        int per_cu = 0;
        if (hipOccupancyMaxActiveBlocksPerMultiprocessor(&per_cu, (const void*)fwd_kernel, NWAVES * 64, LDS_BYTES) != hipSuccess || per_cu < 1) { fprintf(stderr, "kernel_launch: occupancy query says %d\n", per_cu); }
        (void)hipGetLastError();
        grid = cus;
    }
    if (grid < 0) return;
    if (hipMemsetAsync((char*)d_ws + WS_CTL, 0, CTL_ZERO_BYTES, stream) != hipSuccess) return;
    Args a{};
    for (int i = 0; i < 28; ++i) a.in[i] = (const float*)d_in[i];
    a.out = (float*)d_out; a.ws = (unsigned char*)d_ws;
#if MK_N_LAUNCHES == 1
    a.ph_lo = 0; a.ph_hi = N_PHASES;
    hipLaunchKernelGGL(fwd_kernel, dim3(grid), dim3(NWAVES * 64), LDS_BYTES, stream, a);
#else
    for (int p = 0; p < N_PHASES; ++p) { a.ph_lo = p; a.ph_hi = p + 1; hipLaunchKernelGGL(fwd_kernel, dim3(grid), dim3(NWAVES * 64), LDS_BYTES, stream, a); }
#endif
}
```

```cpp
#include <hip/hip_runtime.h>
#include <cstdio>
#include <cstdint>

#ifndef MK_N_LAUNCHES
#define MK_N_LAUNCHES 1
#endif
#ifndef PROBE_PHASE
#define PROBE_PHASE -1
#endif
#ifndef SCAN_V2
#define SCAN_V2 1
#endif
#ifndef USE_PG8
#define USE_PG8 1
#endif

#define LAS __attribute__((address_space(3)))
#define GAS __attribute__((address_space(1)))
typedef unsigned short bf16_t;
typedef short bf16x8 __attribute__((ext_vector_type(8)));
typedef float f32x4 __attribute__((ext_vector_type(4)));
typedef float f32x16 __attribute__((ext_vector_type(16)));
typedef unsigned u32x4 __attribute__((ext_vector_type(4)));
typedef unsigned u32x2 __attribute__((ext_vector_type(2)));

constexpr int BATCH = 8, SEQ = 2048, D = 1024, M = BATCH * SEQ, DFF = 2816, NH = 16, HD = 64, NKV = 4;
constexpr int NBIG = 3584;
constexpr int KBIG = 2048;
constexpr int NL2 = 4096, KL2 = 256, LDL1 = 512;
constexpr int NQKV = 1536;
constexpr float RMS_EPS = 1e-6f, GN_EPS = 64e-5f;
constexpr float LOG2E = 1.4426950408889634f;
constexpr float QSCALE = 0.125f * LOG2E;

constexpr size_t MiB = 1u << 20;
constexpr size_t WS_CTL = 0, CTL_ZERO_BYTES = 1 * MiB;
constexpr size_t WS_ROPE = 1 * MiB;
constexpr size_t WS_BIASQ = 1 * MiB + 768 * 1024;
constexpr size_t WS_BIAS4 = 1 * MiB + 512 * 1024;
constexpr size_t WS_WBIG = 2 * MiB, WS_WL2 = 16 * MiB, WS_WOR = 18 * MiB;
constexpr size_t WS_WQKV = 20 * MiB, WS_WOA = 23 * MiB;
constexpr size_t WS_WGU_A = 25 * MiB, WS_WD_A = 36 * MiB;
constexpr size_t WS_WGU_B = 42 * MiB, WS_WD_B = 53 * MiB;
constexpr size_t WS_XCH = 59 * MiB;
constexpr size_t WS_XN = 64 * MiB;
constexpr size_t WS_R = 97 * MiB, WS_K = 129 * MiB, WS_V = 161 * MiB, WS_VF = 193 * MiB, WS_AG = 225 * MiB, WS_GG = 257 * MiB, WS_VG = 289 * MiB, WS_L1 = 321 * MiB, WS_END = 337 * MiB;
constexpr size_t WS_LW = WS_XN, WS_YG = WS_R, WS_XN2 = WS_K, WS_TMP = WS_V, WS_H = WS_AG;
constexpr size_t WS_Q = WS_R, WS_KA = WS_K, WS_VA = WS_K + 8 * MiB, WS_O = WS_AG;
static_assert(WS_WBIG + (size_t)NBIG * KBIG * 2 <= WS_WL2 && WS_WL2 + (size_t)NL2 * KL2 * 2 <= WS_WOR && WS_WOR + (size_t)D * D * 2 <= WS_WQKV, "ws map 1");
static_assert(WS_WQKV + (size_t)NQKV * D * 2 <= WS_WOA && WS_WOA + (size_t)D * D * 2 <= WS_WGU_A, "ws map 2");
static_assert(WS_WGU_A + (size_t)2 * DFF * D * 2 <= WS_WD_A && WS_WD_A + (size_t)D * DFF * 2 <= WS_WGU_B && WS_WGU_B + (size_t)2 * DFF * D * 2 <= WS_WD_B && WS_WD_B + (size_t)D * DFF * 2 <= WS_XCH, "ws map 3");
static_assert(WS_XN + (size_t)(BATCH * (SEQ + 1)) * D * 2 <= WS_R && WS_H + (size_t)M * DFF * 2 <= WS_L1, "ws map 4");

constexpr int CW_TMO = 0, CW_CODE = 1, CW_BAR = 4096;

#define LDS_WAIT() asm volatile("s_waitcnt lgkmcnt(0)" ::: "memory")
#define VM_WAIT() asm volatile("s_waitcnt vmcnt(0)" ::: "memory")
#define RLX_AGENT __ATOMIC_RELAXED, __HIP_MEMORY_SCOPE_AGENT
__device__ __forceinline__ unsigned f2bf(float f) { unsigned u = __builtin_bit_cast(unsigned, f); return (u + 0x7fffu + ((u >> 16) & 1u)) >> 16; }
__device__ __forceinline__ unsigned pk2(float lo, float hi) { return f2bf(lo) | (f2bf(hi) << 16); }
__device__ __forceinline__ float bf2f(unsigned short b) { return __builtin_bit_cast(float, (unsigned)b << 16); }
__device__ __forceinline__ float bflo(unsigned w) { return __builtin_bit_cast(float, w << 16); }
__device__ __forceinline__ float bfhi(unsigned w) { return __builtin_bit_cast(float, w & 0xffff0000u); }
__device__ __forceinline__ float sigmoidf_(float x) { return 1.0f / (1.0f + __expf(-x)); }
__device__ __forceinline__ int lane_id() { int l; asm volatile("v_mbcnt_lo_u32_b32 %0, -1, 0\n\tv_mbcnt_hi_u32_b32 %0, -1, %0" : "=v"(l)); return l; }
__device__ __forceinline__ float tanh_fast(float x) { const float e = __expf(2.0f * fminf(fmaxf(x, -15.f), 15.f)); return (e - 1.0f) / (e + 1.0f); }
__device__ __forceinline__ float logdecay(float u) { const float z = -u; const float sp = fmaxf(z, 0.f) + __logf(1.0f + __expf(-fabsf(z))); return -__expf(-sp - 0.5f); }
__device__ __forceinline__ float wave_sum(float v) {
#pragma unroll
    for (int o = 1; o < 64; o <<= 1) v += __shfl_xor(v, o);
    return v;
}
__device__ __forceinline__ float sum8(float v) { v += __shfl_xor(v, 1); v += __shfl_xor(v, 2); v += __shfl_xor(v, 4); return v; }
__device__ __forceinline__ void unpack8(const u32x4 w, float (&o)[8]) { o[0] = bflo(w.x); o[1] = bfhi(w.x); o[2] = bflo(w.y); o[3] = bfhi(w.y); o[4] = bflo(w.z); o[5] = bfhi(w.z); o[6] = bflo(w.w); o[7] = bfhi(w.w); }

namespace pg8 {
constexpr int BM = 256, BK = 64, HALF = 128, HTB = HALF * BK * 2, STAGE_BYTES = 8 * HTB, NXCD = 8, WGM = 8;
__host__ __device__ __forceinline__ int lds_byte(int r, int c) { const int st = (r >> 4) * 2 + (c >> 5), rr = r & 15, cc = c & 31, ob = rr * 64 + cc * 2; return st * 1024 + (ob ^ (((ob >> 9) & 1) << 5)); }
__host__ __device__ __forceinline__ void stage_rc(int b, int& R, int& C) { const int st = b / 1024, sb = b % 1024, swz = sb ^ (((sb >> 9) & 1) << 5); R = (st >> 1) * 16 + swz / 64; C = (st & 1) * 32 + (swz % 64) / 2; }
__host__ __device__ __forceinline__ int perm32(int rho) { const int n = rho >> 4, i = rho & 15; return 8 * (i >> 2) + 4 * n + (i & 3); }

struct Unit { int pm, pn; };
struct Gemm {
    const bf16_t* A; const bf16_t* Bt; int M, N, K, lda, ldb;
    int a_mode;
    int a_coltile, a_coloff;
    __device__ __forceinline__ const char* a_ptr(int pm, int pn) const {
        const size_t row = (size_t)pm * 256 + (a_mode == 0 ? 0 : (pm >> 3) + (a_mode == 1 ? 1 : 0));
        return (const char*)(A + row * lda + (pn >= a_coltile ? a_coloff : 0));
    }
    __device__ __forceinline__ const char* b_ptr(int pn) const { return (const char*)(Bt + (size_t)pn * 256 * ldb); }
};
struct StaticOrder {
    int nM, nN, nwg, G, c;
    __host__ __device__ void init(int M_, int N_, int G_, int c_) { nM = M_ / BM; nN = N_ / BM; nwg = nM * nN; G = G_; c = c_; }
    __host__ __device__ bool next(int i, Unit& u) const {
        const long L = (long)i * G + c; if (L >= nwg) return false;
        int wgid = (int)L; { const int q = nwg / NXCD, r = nwg % NXCD, xcd = wgid % NXCD, off = wgid / NXCD; wgid = (xcd < r ? xcd * (q + 1) : r * (q + 1) + (xcd - r) * q) + off; }
        const int nig = WGM * nN, gid = wgid / nig, fm = gid * WGM, gsz = (nM - fm) < WGM ? (nM - fm) : WGM;
        u.pm = fm + ((wgid % nig) % gsz); u.pn = (wgid % nig) / gsz; return true;
    }
};

template <class Epi>
__device__ __forceinline__ void gemm_simple(const Gemm g, int G, int c, const Epi& E, int tid) {
    const int wid = __builtin_amdgcn_readfirstlane(tid >> 6), lane = tid & 63, wr = wid >> 2, wc = wid & 3, fr = lane & 15, fq = lane >> 4;
    StaticOrder S; S.init(g.M, g.N, G, c);
    Unit u;
    for (int i = 0; S.next(i, u); ++i) {
        f32x4 acc[2][2][4][2];
#pragma unroll
        for (int a = 0; a < 2; ++a)
#pragma unroll
            for (int b = 0; b < 2; ++b)
#pragma unroll
                for (int m = 0; m < 4; ++m)
#pragma unroll
                    for (int n = 0; n < 2; ++n) acc[a][b][m][n] = (f32x4){0.f, 0.f, 0.f, 0.f};
        const char* Ab = g.a_ptr(u.pm, u.pn);
        const char* Bb = g.b_ptr(u.pn);
        const unsigned aoff = (unsigned)((wr * 64 + fr) * g.lda + fq * 8) * 2u;
        unsigned boff[2];
#pragma unroll
        for (int n = 0; n < 2; ++n) { const int rho = 16 * n + fr; boff[n] = (unsigned)((wc * 32 + (Epi::PERM ? perm32(rho) : rho)) * g.ldb + fq * 8) * 2u; }
        const unsigned a16 = (unsigned)(16 * g.lda) * 2u, a128 = 8u * a16, b128 = (unsigned)(128 * g.ldb) * 2u;
#pragma unroll 1
        for (int k0 = 0; k0 < g.K; k0 += 32) {
            bf16x8 b[2][2];
#pragma unroll
            for (int bj = 0; bj < 2; ++bj)
#pragma unroll
                for (int n = 0; n < 2; ++n) b[bj][n] = *(const bf16x8*)(Bb + (boff[n] + bj * b128 + (unsigned)k0 * 2u));
#pragma unroll
            for (int ai = 0; ai < 2; ++ai) {
                bf16x8 a[4];
#pragma unroll
                for (int m = 0; m < 4; ++m) a[m] = *(const bf16x8*)(Ab + (aoff + ai * a128 + m * a16 + (unsigned)k0 * 2u));
#pragma unroll
                for (int bj = 0; bj < 2; ++bj)
#pragma unroll
                    for (int m = 0; m < 4; ++m)
#pragma unroll
                        for (int n = 0; n < 2; ++n) acc[ai][bj][m][n] = __builtin_amdgcn_mfma_f32_16x16x32_bf16(b[bj][n], a[m], acc[ai][bj][m][n], 0, 0, 0);
            }
        }
        asm volatile("" ::: "memory");
        E(acc, u, wr, wc, fr, fq);
    }
}
template <class Epi, bool ALIGN_EPI = false, bool SP2 = false>
__device__ __forceinline__ void gemm_phase(LAS unsigned char* lds, const Gemm g, const StaticOrder& S, const Epi& E, int tid) {
    const int wid = __builtin_amdgcn_readfirstlane(tid >> 6), lane = tid & 63, wr = wid >> 2, wc = wid & 3, fr = lane & 15, fq = lane >> 4;
    const int K = g.K, nt = K / BK;
    unsigned voffA[2], voffB[2];
#pragma unroll
    for (int i = 0; i < 2; ++i) { int R, C; stage_rc(tid * 16 + i * 8192, R, C); const int Rb = Epi::PERM ? ((R & ~31) + perm32(R & 31)) : R;
        voffA[i] = (unsigned)(R * g.lda + C) * 2u; voffB[i] = (unsigned)(Rb * g.ldb + C) * 2u; }
    const size_t kstep = (size_t)(BK * 2);
    const size_t hstepA = (size_t)HALF * g.lda * 2, hstepB = (size_t)HALF * g.ldb * 2;
    const unsigned ldsw = (unsigned)wid * 1024u;
    const int aoff = lds_byte(wr * 64 + fr, fq * 8), boff = lds_byte(wc * 32 + fr, fq * 8);
#define PG8_SA(b, h) (((b) * 2 + (h)) * HTB)
#define PG8_SB(b, h) ((4 + (b) * 2 + (h)) * HTB)
#define PG8_STAGE(bufoff, gbase, voff) do { _Pragma("unroll") for (int _i = 0; _i < 2; ++_i) \
        __builtin_amdgcn_global_load_lds((const unsigned*)((const char*)(gbase) + (voff)[_i]), (LAS unsigned*)(lds + (bufoff) + ldsw + _i * 8192), 16, 0, 0); } while (0)
#define PG8_LDA(dst, b, h) do { _Pragma("unroll") for (int m = 0; m < 4; ++m) _Pragma("unroll") for (int k = 0; k < 2; ++k) dst[m][k] = *(const LAS bf16x8*)(lds + PG8_SA(b, h) + aoff + m * 2048 + k * 1024); } while (0)
#define PG8_LDB(dst, b, h) do { _Pragma("unroll") for (int n = 0; n < 2; ++n) _Pragma("unroll") for (int k = 0; k < 2; ++k) dst[n][k] = *(const LAS bf16x8*)(lds + PG8_SB(b, h) + boff + n * 2048 + k * 1024); } while (0)
#define PG8_MMA(ai, bj, At, Bt) do { __builtin_amdgcn_s_setprio(1); _Pragma("unroll") for (int m = 0; m < 4; ++m) _Pragma("unroll") for (int n = 0; n < 2; ++n) _Pragma("unroll") for (int k = 0; k < 2; ++k) \
        acc[ai][bj][m][n] = __builtin_amdgcn_mfma_f32_16x16x32_bf16(Bt[n][k], At[m][k], acc[ai][bj][m][n], 0, 0, 0); __builtin_amdgcn_s_setprio(0); } while (0)
#define PG8_WAIT_V(n) asm volatile("s_waitcnt vmcnt(" #n ")" ::: "memory")
#define PG8_WAIT_L(n) asm volatile("s_waitcnt lgkmcnt(" #n ")" ::: "memory")
#define PG8_BAR __builtin_amdgcn_s_barrier()
#define PG8_SCHED __builtin_amdgcn_sched_barrier(0)
    Unit cur, nxt; int ui = 0;
    if (!S.next(0, cur)) return;
    f32x4 acc[2][2][4][2];
#pragma unroll
    for (int a = 0; a < 2; ++a)
#pragma unroll
        for (int b = 0; b < 2; ++b)
#pragma unroll
            for (int m = 0; m < 4; ++m)
#pragma unroll
                for (int n = 0; n < 2; ++n) acc[a][b][m][n] = (f32x4){0.f, 0.f, 0.f, 0.f};
    bf16x8 At[4][2], B0[2][2], B1[2][2];
    const char* cA = g.a_ptr(cur.pm, cur.pn); const char* cB = g.b_ptr(cur.pn);
    if constexpr (SP2) {
        PG8_STAGE(PG8_SB(0, 0), cB, voffB); PG8_STAGE(PG8_SB(0, 1), cB + hstepB, voffB); PG8_STAGE(PG8_SA(0, 0), cA, voffA); PG8_STAGE(PG8_SA(0, 1), cA + hstepA, voffA);
        if (wr == 1) PG8_BAR;
        PG8_WAIT_V(2); PG8_BAR;
        PG8_STAGE(PG8_SB(1, 0), cB + kstep, voffB); PG8_STAGE(PG8_SA(1, 0), cA + kstep, voffA); PG8_STAGE(PG8_SB(1, 1), cB + hstepB + kstep, voffB);
        PG8_WAIT_V(6); PG8_BAR;
    } else {
        PG8_STAGE(PG8_SB(0, 0), cB, voffB); PG8_STAGE(PG8_SA(0, 0), cA, voffA); PG8_STAGE(PG8_SB(0, 1), cB + hstepB, voffB); PG8_STAGE(PG8_SA(0, 1), cA + hstepA, voffA);
        if (wr == 1) PG8_BAR;
        PG8_WAIT_V(4); PG8_BAR;
        PG8_STAGE(PG8_SB(1, 0), cB + kstep, voffB); PG8_STAGE(PG8_SA(1, 0), cA + kstep, voffA); PG8_STAGE(PG8_SB(1, 1), cB + hstepB + kstep, voffB);
        PG8_WAIT_V(6); PG8_BAR;
    }
    for (;;) {
        const bool has_next = S.next(ui + 1, nxt);
        const char* nA = has_next ? g.a_ptr(nxt.pm, nxt.pn) : cA; const char* nB = has_next ? g.b_ptr(nxt.pn) : cB;
        for (int t = 0; t < nt; t += 2) {
            const bool last = (t == nt - 2);
            const char* a1 = cA + (size_t)(t + 1) * kstep;
            const char* a2 = last ? nA : cA + (size_t)(t + 2) * kstep; const char* b2 = last ? nB : cB + (size_t)(t + 2) * kstep;
            const char* a3 = a2 + kstep; const char* b3 = b2 + kstep;
            if constexpr (SP2) {
            PG8_LDB(B0, 0, 0); PG8_LDB(B1, 0, 1); PG8_SCHED; PG8_LDA(At, 0, 0); PG8_STAGE(PG8_SA(1, 1), a1 + hstepA, voffA);
            PG8_WAIT_V(8); PG8_WAIT_L(0); PG8_BAR; PG8_MMA(0, 0, At, B0); PG8_MMA(0, 1, At, B1); PG8_BAR; PG8_SCHED;
            PG8_LDA(At, 0, 1); PG8_STAGE(PG8_SB(0, 0), b2, voffB); PG8_STAGE(PG8_SB(0, 1), b2 + hstepB, voffB); PG8_STAGE(PG8_SA(0, 0), a2, voffA);
            PG8_WAIT_V(8); PG8_WAIT_L(0); PG8_BAR; PG8_MMA(1, 0, At, B0); PG8_MMA(1, 1, At, B1); PG8_BAR; PG8_SCHED;
            PG8_LDB(B0, 1, 0); PG8_LDB(B1, 1, 1); PG8_SCHED; PG8_LDA(At, 1, 0); PG8_STAGE(PG8_SA(0, 1), a2 + hstepA, voffA);
            PG8_WAIT_V(8); PG8_WAIT_L(0); PG8_BAR; PG8_MMA(0, 0, At, B0); PG8_MMA(0, 1, At, B1); PG8_BAR; PG8_SCHED;
            PG8_LDA(At, 1, 1); PG8_STAGE(PG8_SB(1, 0), b3, voffB); PG8_STAGE(PG8_SB(1, 1), b3 + hstepB, voffB); PG8_STAGE(PG8_SA(1, 0), a3, voffA);
            PG8_WAIT_V(8); PG8_WAIT_L(0); PG8_BAR; PG8_MMA(1, 0, At, B0); PG8_MMA(1, 1, At, B1); PG8_BAR; PG8_SCHED;
            } else {
            PG8_LDB(B0, 0, 0); PG8_SCHED; PG8_LDA(At, 0, 0); PG8_STAGE(PG8_SA(1, 1), a1 + hstepA, voffA);
            PG8_WAIT_L(8); PG8_BAR; PG8_WAIT_L(0); PG8_MMA(0, 0, At, B0); PG8_BAR; PG8_SCHED;
            PG8_LDB(B1, 0, 1); PG8_STAGE(PG8_SB(0, 0), b2, voffB);
            PG8_BAR; PG8_WAIT_L(0); PG8_MMA(0, 1, At, B1); PG8_BAR;
            PG8_LDA(At, 0, 1); PG8_STAGE(PG8_SA(0, 0), a2, voffA);
            PG8_BAR; PG8_WAIT_L(0); PG8_MMA(1, 0, At, B0); PG8_BAR; PG8_SCHED;
            PG8_STAGE(PG8_SB(0, 1), b2 + hstepB, voffB);
            PG8_WAIT_V(6); PG8_BAR; PG8_MMA(1, 1, At, B1); PG8_BAR;
            PG8_LDB(B0, 1, 0); PG8_SCHED; PG8_LDA(At, 1, 0); PG8_STAGE(PG8_SA(0, 1), a2 + hstepA, voffA);
            PG8_WAIT_L(8); PG8_BAR; PG8_WAIT_L(0); PG8_MMA(0, 0, At, B0); PG8_BAR; PG8_SCHED;
            PG8_LDB(B1, 1, 1); PG8_STAGE(PG8_SB(1, 0), b3, voffB);
            PG8_BAR; PG8_WAIT_L(0); PG8_MMA(0, 1, At, B1); PG8_BAR;
            PG8_LDA(At, 1, 1); PG8_STAGE(PG8_SA(1, 0), a3, voffA);
            PG8_BAR; PG8_WAIT_L(0); PG8_MMA(1, 0, At, B0); PG8_BAR; PG8_SCHED;
            PG8_STAGE(PG8_SB(1, 1), b3 + hstepB, voffB);
            PG8_WAIT_V(6); PG8_BAR; PG8_MMA(1, 1, At, B1); PG8_BAR;
            }
        }
        if constexpr (ALIGN_EPI) { if (wr == 0) PG8_BAR; }
        if constexpr (!Epi::AFTER_DRAIN) { E(acc, cur, wr, wc, fr, fq); }
        if (!has_next) break;
#pragma unroll
        for (int a = 0; a < 2; ++a)
#pragma unroll
            for (int b = 0; b < 2; ++b)
#pragma unroll
                for (int m = 0; m < 4; ++m)
#pragma unroll
                    for (int n = 0; n < 2; ++n) acc[a][b][m][n] = (f32x4){0.f, 0.f, 0.f, 0.f};
        cur = nxt; cA = nA; cB = nB; ++ui;
        if constexpr (ALIGN_EPI) { if (wr == 1) PG8_BAR; }
    }
    PG8_WAIT_V(0);
    if constexpr (!ALIGN_EPI) { if (wr == 0) PG8_BAR; }
    PG8_BAR;
    if constexpr (Epi::AFTER_DRAIN) { E.fused(acc, cur, wr, wc, fr, fq, lds, wid, lane); }
#undef PG8_SA
#undef PG8_SB
#undef PG8_STAGE
#undef PG8_LDA
#undef PG8_LDB
#undef PG8_MMA
#undef PG8_WAIT_V
#undef PG8_WAIT_L
#undef PG8_BAR
#undef PG8_SCHED
}
}

namespace epi {
using pg8::Unit; using pg8::BM; using pg8::HALF;
__device__ __forceinline__ u32x4 pack8(const f32x4 v0, const f32x4 v1) { u32x4 w; w.x = pk2(v0[0], v0[1]); w.y = pk2(v0[2], v0[3]); w.z = pk2(v1[0], v1[1]); w.w = pk2(v1[2], v1[3]); return w; }

struct Bf16Out {
    static constexpr bool PERM = true, AFTER_DRAIN = false;
    bf16_t* O; int ldc; const float* bias;
    __device__ __forceinline__ void operator()(const f32x4 (&acc)[2][2][4][2], const Unit& u, int wr, int wc, int fr, int fq) const {
        const int row0 = u.pm * BM + wr * 64 + fr, col0 = u.pn * BM + wc * 32 + 8 * fq;
#pragma unroll
        for (int bj = 0; bj < 2; ++bj) {
            f32x4 b0 = (f32x4){0.f, 0.f, 0.f, 0.f}, b1 = b0;
            if (bias) { b0 = *(const f32x4*)(bias + col0 + bj * HALF); b1 = *(const f32x4*)(bias + col0 + bj * HALF + 4); }
#pragma unroll
            for (int ai = 0; ai < 2; ++ai)
#pragma unroll
                for (int m = 0; m < 4; ++m) {
                    bf16_t* p = O + (size_t)(row0 + ai * HALF + m * 16) * ldc + col0 + bj * HALF;
                    *(u32x4*)p = pack8(acc[ai][bj][m][0] + b0, acc[ai][bj][m][1] + b1);
                }
        }
    }
};

struct BigOut {
    static constexpr bool PERM = true, AFTER_DRAIN = false;
    unsigned char* ws; size_t v_off;
    __device__ __forceinline__ void operator()(const f32x4 (&acc)[2][2][4][2], const Unit& u, int wr, int wc, int fr, int fq) const {
        const int row0 = u.pm * BM + wr * 64 + fr;
        const int grp = u.pn >> 2;
        size_t boff = WS_R + (size_t)grp * (32 * MiB); if (grp == 2) boff = v_off; if (grp == 3) boff = WS_L1;
        bf16_t* base = (bf16_t*)(ws + boff);
        const int ldc = (grp == 3) ? LDL1 : D, colt = (grp == 3) ? (u.pn - 12) * BM : (u.pn & 3) * BM;
        int act0 = 0, act1 = 0;
        if (u.pn == 12) { act0 = (wc < 2) ? 1 : 0; act1 = 2; }
        const int col0 = colt + wc * 32 + 8 * fq;
#pragma unroll
        for (int bj = 0; bj < 2; ++bj) {
            const int act = bj ? act1 : act0;
#pragma unroll
            for (int ai = 0; ai < 2; ++ai)
#pragma unroll
                for (int m = 0; m < 4; ++m) {
                    f32x4 v0 = acc[ai][bj][m][0], v1 = acc[ai][bj][m][1];
                    if (act == 1) {
#pragma unroll
                        for (int j = 0; j < 4; ++j) { v0[j] = tanh_fast(v0[j]); v1[j] = tanh_fast(v1[j]); }
                    } else if (act == 2) {
#pragma unroll
                        for (int j = 0; j < 4; ++j) { v0[j] = sigmoidf_(v0[j]); v1[j] = sigmoidf_(v1[j]); }
                    }
                    *(u32x4*)(base + (size_t)(row0 + ai * HALF + m * 16) * ldc + col0 + bj * HALF) = pack8(v0, v1);
                }
        }
    }
};

struct L2Out {
    static constexpr bool PERM = true, AFTER_DRAIN = false;
    unsigned char* ws; const float* bias4;
    __device__ __forceinline__ void operator()(const f32x4 (&acc)[2][2][4][2], const Unit& u, int wr, int wc, int fr, int fq) const {
        const int row0 = u.pm * BM + wr * 64 + fr, grp = u.pn >> 2, col0 = (u.pn & 3) * BM + wc * 32 + 8 * fq;
        bf16_t* base = (bf16_t*)(ws + (grp == 0 ? WS_LW : WS_AG + (size_t)(grp - 1) * (32 * MiB)));
        const float* bias = bias4 + grp * D;
#pragma unroll
        for (int bj = 0; bj < 2; ++bj) {
            const f32x4 b0 = *(const f32x4*)(bias + col0 + bj * HALF), b1 = *(const f32x4*)(bias + col0 + bj * HALF + 4);
#pragma unroll
            for (int ai = 0; ai < 2; ++ai)
#pragma unroll
                for (int m = 0; m < 4; ++m) {
                    f32x4 v0_ = acc[ai][bj][m][0] + b0, v1_ = acc[ai][bj][m][1] + b1;
                    if (grp == 0) {
#pragma unroll
                        for (int j = 0; j < 4; ++j) { v0_[j] = logdecay(v0_[j]); v1_[j] = logdecay(v1_[j]); }
                    } else if (grp != 2) {
#pragma unroll
                        for (int j = 0; j < 4; ++j) { v0_[j] = sigmoidf_(v0_[j]); v1_[j] = sigmoidf_(v1_[j]); }
                    }
                    *(u32x4*)(base + (size_t)(row0 + ai * HALF + m * 16) * D + col0 + bj * HALF) = pack8(v0_, v1_);
                }
        }
    }
};

struct QkvOut {
    static constexpr bool PERM = true, AFTER_DRAIN = false;
    unsigned char* ws; const float* bias; const float* rope;
    __device__ __forceinline__ void operator()(const f32x4 (&acc)[2][2][4][2], const Unit& u, int wr, int wc, int fr, int fq) const {
        const int row0 = u.pm * BM + wr * 64 + fr;
        const bool isq = u.pn < 4;
        bf16_t* base = (bf16_t*)(ws + (isq ? WS_Q : WS_KA + (size_t)(u.pn - 4) * (8 * MiB)));
        const int ldc = isq ? D : 256, colt = isq ? u.pn * BM : 0; const float sc = isq ? QSCALE : 1.f;
        const bool rot = (u.pn < 5) && ((wc & 1) == 0) && (fq < 2);
#pragma unroll
        for (int bj = 0; bj < 2; ++bj) {
            const int cl = bj * HALF + wc * 32 + 8 * fq;
            const int scol = u.pn * BM + cl;
            const f32x4 bv0 = *(const f32x4*)(bias + scol), bv1 = *(const f32x4*)(bias + scol + 4);
#pragma unroll
            for (int ai = 0; ai < 2; ++ai)
#pragma unroll
                for (int m = 0; m < 4; ++m) {
                    const int row = row0 + ai * HALF + m * 16;
                    float v[8];
#pragma unroll
                    for (int i = 0; i < 4; ++i) { v[i] = acc[ai][bj][m][0][i] + bv0[i]; v[4 + i] = acc[ai][bj][m][1][i] + bv1[i]; }
                    if (rot) {
                        const int pos = row & (SEQ - 1);
                        const f32x4 cs = *(const f32x4*)(rope + pos * 8 + 4 * fq), sn = *(const f32x4*)(rope + SEQ * 8 + pos * 8 + 4 * fq);
#pragma unroll
                        for (int i = 0; i < 4; ++i) { const float x1 = v[2 * i], x2 = v[2 * i + 1]; v[2 * i] = x1 * cs[i] - x2 * sn[i]; v[2 * i + 1] = x2 * cs[i] + x1 * sn[i]; }
                    }
                    u32x4 w; w.x = pk2(v[0] * sc, v[1] * sc); w.y = pk2(v[2] * sc, v[3] * sc); w.z = pk2(v[4] * sc, v[5] * sc); w.w = pk2(v[6] * sc, v[7] * sc);
                    *(u32x4*)(base + (size_t)row * ldc + colt + cl) = w;
                }
        }
    }
};

struct SwigluOut {
    static constexpr bool PERM = true, AFTER_DRAIN = false;
    bf16_t* H;
    __device__ __forceinline__ void operator()(const f32x4 (&acc)[2][2][4][2], const Unit& u, int wr, int wc, int fr, int fq) const {
        const int row0 = u.pm * BM + wr * 64 + fr, col0 = u.pn * HALF + wc * 32 + 8 * fq;
#pragma unroll
        for (int ai = 0; ai < 2; ++ai)
#pragma unroll
            for (int m = 0; m < 4; ++m) {
                f32x4 o0, o1;
#pragma unroll
                for (int j = 0; j < 4; ++j) {
                    const float g0 = acc[ai][0][m][0][j], g1 = acc[ai][0][m][1][j];
                    o0[j] = g0 * sigmoidf_(g0) * acc[ai][1][m][0][j]; o1[j] = g1 * sigmoidf_(g1) * acc[ai][1][m][1][j];
                }
                *(u32x4*)(H + (size_t)(row0 + ai * HALF + m * 16) * DFF + col0) = pack8(o0, o1);
            }
    }
};
}

#define XB_TMO      128
#define XB_XCNT(j)  (256  + 64 * (j))
#define XB_XSUB(j)  (1280 + 64 * (j))
#define XB_XGEN(j)  (2304 + 64 * (j))
#define XB_TOP      3328
#define XB_TOPGEN   3392
#define XCD_BAR_WORDS 3456
#define XB_SPIN_CAP (1u << 22)
__device__ __forceinline__ unsigned xb_ld(unsigned* p)              { return __hip_atomic_load(p, __ATOMIC_RELAXED, __HIP_MEMORY_SCOPE_AGENT); }
__device__ __forceinline__ unsigned xb_add(unsigned* p, unsigned v) { return __hip_atomic_fetch_add(p, v, __ATOMIC_RELAXED, __HIP_MEMORY_SCOPE_AGENT); }
__device__ __forceinline__ unsigned xb_xcc_id() { return (unsigned)__builtin_amdgcn_s_getreg((3 << 11) | 20) & 0xFu; }
#define XB_SPIN(cond, bar) do { unsigned _sp = 0; while (cond) { __builtin_amdgcn_s_sleep(1); \
    if ((++_sp & 255u) == 0u) { if (xb_ld(&(bar)[XB_TMO])) break; if (_sp > XB_SPIN_CAP) { atomicAdd(&(bar)[XB_TMO], 1u); break; } } } } while (0)
struct XcdBarrier { unsigned* bar; unsigned x; volatile LAS unsigned* st; };
__device__ __forceinline__ XcdBarrier xcd_barrier_post(unsigned* bar, volatile LAS unsigned* st, bool leader) {
    XcdBarrier b; b.bar = bar; b.x = xb_xcc_id(); b.st = st;
    if (leader) (void)xb_add(&bar[XB_XCNT(b.x)], 1u);
    return b;
}
__device__ __forceinline__ void xcd_barrier_complete(unsigned* bar, unsigned x, unsigned& nloc, unsigned& nx) {
    const unsigned G = gridDim.x * gridDim.y * gridDim.z;
    unsigned sum, cnt, mine, sp = 0u;
    for (;;) {
        sum = 0u; cnt = 0u; mine = 0u;
#pragma unroll
        for (unsigned j = 0; j < 16; ++j) { const unsigned c = xb_ld(&bar[XB_XCNT(j)]); sum += c; cnt += (c > 0u) ? 1u : 0u; mine = (j == x) ? c : mine; }
        if (sum == G) break;
        __builtin_amdgcn_s_sleep(1);
        if ((++sp & 255u) == 0u) { if (xb_ld(&bar[XB_TMO])) break; if (sp > XB_SPIN_CAP) { atomicAdd(&bar[XB_TMO], 1u); break; } }
    }
    nloc = mine > 0u ? mine : 1u; nx = cnt > 0u ? cnt : 1u;
}
__device__ __forceinline__ void xcd_barrier(const XcdBarrier& b, bool leader) {
    asm volatile("s_waitcnt vmcnt(0)" ::: "memory");
    __syncthreads();
    if (leader) {
        unsigned* bar = b.bar;
        __builtin_amdgcn_s_waitcnt(0);
        unsigned nloc = b.st[0], nx = b.st[1];
        if (nloc == 0u) { xcd_barrier_complete(bar, b.x, nloc, nx); b.st[0] = nloc; b.st[1] = nx; }
        const unsigned old = xb_add(&bar[XB_XSUB(b.x)], 1u);
        const unsigned gen = old / nloc;
        if (old + 1u == (gen + 1u) * nloc) {
            __builtin_amdgcn_fence(__ATOMIC_RELEASE, "agent");
            asm volatile("s_waitcnt vmcnt(0)" ::: "memory");
            const unsigned og = xb_add(&bar[XB_TOP], 1u);
            const unsigned tg = og / nx;
            if (og + 1u == (tg + 1u) * nx) xb_add(&bar[XB_TOPGEN], 1u);
            else XB_SPIN(xb_ld(&bar[XB_TOPGEN]) == tg, bar);
            __builtin_amdgcn_fence(__ATOMIC_ACQUIRE, "agent");
            xb_add(&bar[XB_XGEN(b.x)], 1u);
            asm volatile("s_waitcnt vmcnt(0)" ::: "memory");
        } else {
            XB_SPIN(xb_ld(&bar[XB_XGEN(b.x)]) == gen, bar);
            __builtin_amdgcn_fence(__ATOMIC_ACQUIRE, "agent");
            asm volatile("s_waitcnt vmcnt(0)" ::: "memory");
        }
    }
    __syncthreads();
}

constexpr int RING_OFF = 0, RING_BYTES = 131072;
constexpr int LDSCTL_OFF = RING_BYTES, MISC_OFF = LDSCTL_OFF + 320;
constexpr int LDS_BYTES = 147456;
constexpr int NWAVES = 8;

struct Args { const float* in[28]; float* out; unsigned char* ws; int ph_lo, ph_hi; };
typedef const float* const __attribute__((address_space(4))) * InTab;
static_assert(offsetof(Args, out) == 224 && offsetof(Args, ws) == 232, "kernarg layout");
enum { I_X = 0, I_NORMG, I_XMIX, I_WRKV, I_W0, I_W1, I_W2, I_A0, I_A1, I_A2, I_V0, I_V1, I_V2, I_G1, I_G2, I_KK, I_KA, I_RK, I_LNW, I_LNB, I_WOR,
       I_WQKV, I_BQKV, I_SINK, I_WOA, I_BOA, I_WGU, I_WD };

template <class F>
__device__ __forceinline__ void cvt_matrix(bf16_t* WT, int N, int K, const F& f, LAS float* scr, int gw, int NGW, int lane) {
    const int nblk = N / 32, nitems = nblk * (K / 64);
    for (int it = gw; it < nitems; it += NGW) {
        const int kb = it / nblk, nb = it % nblk, k0 = 64 * kb, n0 = 32 * nb;
#pragma unroll 8
        for (int i = 0; i < 32; ++i) { const int kk = 2 * i + (lane >> 5); scr[kk * 33 + (lane & 31)] = f(n0 + (lane & 31), k0 + kk); }
        LDS_WAIT(); asm volatile("" ::: "memory");
        const int c = lane & 7;
#pragma unroll
        for (int j = 0; j < 4; ++j) { const int n = (lane >> 3) + 8 * j; const LAS float* s = scr + (8 * c) * 33 + n;
            u32x4 o; o.x = pk2(s[0 * 33], s[1 * 33]); o.y = pk2(s[2 * 33], s[3 * 33]); o.z = pk2(s[4 * 33], s[5 * 33]); o.w = pk2(s[6 * 33], s[7 * 33]);
            *(u32x4*)(WT + (size_t)(n0 + n) * K + k0 + 8 * c) = o; }
        LDS_WAIT(); asm volatile("" ::: "memory");
    }
}
struct FBig {
    const float *wrkv, *w1, *a1, *g1, *v1, *mix; int has_v;
    __device__ __forceinline__ float operator()(int n, int k) const {
        const int kk = k & 1023; float w; int mi;
        if (n < 3072) { mi = n >> 10; w = wrkv[((size_t)mi * D + kk) * D + (n & 1023)]; }
        else if (n < 3136) { mi = 3; w = w1[kk * 64 + (n - 3072)]; }
        else if (n < 3200) { mi = 4; w = a1[kk * 64 + (n - 3136)]; }
        else if (n < 3328) { mi = 5; w = g1[kk * 128 + (n - 3200)]; }
        else if (n < 3360 && has_v) { mi = 2; w = v1[kk * 32 + (n - 3328)]; }
        else return 0.f;
        const float mx = mix[mi * D + kk];
        return w * (k < 1024 ? mx : 1.0f - mx);
    }
};
struct FL2 {
    const float *w2, *a2, *g2, *v2; int has_v;
    __device__ __forceinline__ float operator()(int n, int k) const {
        const int grp = n >> 10, c = n & 1023;
        if (grp == 0) return k < 64 ? w2[k * D + c] : 0.f;
        if (grp == 1) return (k >= 64 && k < 128) ? a2[(k - 64) * D + c] : 0.f;
        if (grp == 2) return k >= 128 ? g2[(k - 128) * D + c] : 0.f;
        return (k < 32 && has_v) ? v2[k * D + c] : 0.f;
    }
};
struct FPlain { const float* W; int N;
    __device__ __forceinline__ float operator()(int n, int k) const { return W[(size_t)k * N + n]; } };
struct FQkv { const float* W;
    __device__ __forceinline__ float operator()(int n, int k) const { int sn = n; if (n < 1280) { const int dp = n & 63; if (dp < 16) sn = (n & ~63) + (dp >> 1) + 8 * (dp & 1); } return W[(size_t)k * NQKV + sn]; } };
struct FGu { const float* W;
    __device__ __forceinline__ float operator()(int n, int k) const { const int t = n >> 8, r = n & 255; const int sn = (r < 128) ? t * 128 + r : DFF + t * 128 + (r - 128); return W[(size_t)k * (2 * DFF) + sn]; } };

__device__ __forceinline__ void cvt_rwkv(InTab a, int j, unsigned char* ws, LAS float* scr, int gw, int NGW, int lane) {
    FBig fb{a[I_WRKV] + (size_t)j * 3 * D * D, a[I_W1] + (size_t)j * D * 64, a[I_A1] + (size_t)j * D * 64, a[I_G1] + (size_t)j * D * 128, a[I_V1], a[I_XMIX] + (size_t)j * 6 * D, j > 0 ? 1 : 0};
    cvt_matrix((bf16_t*)(ws + WS_WBIG), NBIG, KBIG, fb, scr, gw, NGW, lane);
    FL2 f2{a[I_W2] + (size_t)j * 64 * D, a[I_A2] + (size_t)j * 64 * D, a[I_G2] + (size_t)j * 128 * D, a[I_V2], j > 0 ? 1 : 0};
    cvt_matrix((bf16_t*)(ws + WS_WL2), NL2, KL2, f2, scr, gw, NGW, lane);
    FPlain fo{a[I_WOR] + (size_t)j * D * D, D};
    cvt_matrix((bf16_t*)(ws + WS_WOR), D, D, fo, scr, gw, NGW, lane);
    for (int e = gw * 64 + lane; e < 4 * D; e += NGW * 64) { const int grp = e >> 10, c = e & 1023; float v = 0.f;
        if (grp == 0) v = a[I_W0][j * D + c]; else if (grp == 1) v = a[I_A0][j * D + c]; else if (grp == 3) v = a[I_V0][c];
        ((float*)(ws + WS_BIAS4))[e] = v; }
}
__device__ __forceinline__ void cvt_attn(InTab a, int j, unsigned char* ws, LAS float* scr, int gw, int NGW, int lane) {
    FQkv fq{a[I_WQKV] + (size_t)j * D * NQKV};
    cvt_matrix((bf16_t*)(ws + WS_WQKV), NQKV, D, fq, scr, gw, NGW, lane);
    FPlain fo{a[I_WOA] + (size_t)j * D * D, D};
    cvt_matrix((bf16_t*)(ws + WS_WOA), D, D, fo, scr, gw, NGW, lane);
    for (int n = gw * 64 + lane; n < NQKV; n += NGW * 64) { int sn = n; if (n < 1280) { const int dp = n & 63; if (dp < 16) sn = (n & ~63) + (dp >> 1) + 8 * (dp & 1); }
        ((float*)(ws + WS_BIASQ))[n] = a[I_BQKV][(size_t)j * NQKV + sn]; }
}
__device__ __forceinline__ void cvt_ffn(InTab a, int i, unsigned char* ws, LAS float* scr, int gw, int NGW, int lane) {
    const size_t ogu = (i & 1) ? WS_WGU_B : WS_WGU_A, od = (i & 1) ? WS_WD_B : WS_WD_A;
    FGu fg{a[I_WGU] + (size_t)i * D * 2 * DFF};
    cvt_matrix((bf16_t*)(ws + ogu), 2 * DFF, D, fg, scr, gw, NGW, lane);
    FPlain fd{a[I_WD] + (size_t)i * DFF * D, D};
    cvt_matrix((bf16_t*)(ws + od), D, DFF, fd, scr, gw, NGW, lane);
}

__device__ __forceinline__ size_t xn_row(int m) { return (size_t)m + (m >> 11) + 1; }
__device__ __forceinline__ void norm_rows(const float* x, const float* g, bf16_t* xn, int gw, int NGW, int lane) {
    f32x4 gv[4];
#pragma unroll
    for (int j = 0; j < 4; ++j) gv[j] = *((const f32x4*)g + lane + 64 * j);
    for (int m = gw; m < M; m += NGW) {
        const f32x4* xr = (const f32x4*)(x + (size_t)m * D) + lane;
        f32x4 v[4]; float s = 0.f;
#pragma unroll
        for (int j = 0; j < 4; ++j) { v[j] = xr[64 * j]; s += (v[j][0] * v[j][0] + v[j][1] * v[j][1]) + (v[j][2] * v[j][2] + v[j][3] * v[j][3]); }
        const float rstd = 1.0f / sqrtf(wave_sum(s) * (1.f / D) + RMS_EPS);
        u32x2* o = (u32x2*)(xn + xn_row(m) * D) + lane;
#pragma unroll
        for (int j = 0; j < 4; ++j) { u32x2 w; w.x = pk2(v[j][0] * rstd * gv[j][0], v[j][1] * rstd * gv[j][1]); w.y = pk2(v[j][2] * rstd * gv[j][2], v[j][3] * rstd * gv[j][3]); o[64 * j] = w; }
    }
}
__device__ __forceinline__ void resnorm_rows(const bf16_t* tmp, const float* xin, float* xout, const float* ga, const float* gb, bf16_t* xn, bool guard, int gw, int NGW, int lane) {
    for (int m = gw; m < M; m += NGW) {
        const u32x2* tr = (const u32x2*)(tmp + (size_t)m * D) + lane;
        const f32x4* xr = (const f32x4*)(xin + (size_t)m * D) + lane;
        f32x4 t[4], v[4]; float s = 0.f;
#pragma unroll
        for (int j = 0; j < 4; ++j) { const u32x2 w = tr[64 * j]; t[j] = (f32x4){bflo(w.x), bfhi(w.x), bflo(w.y), bfhi(w.y)}; v[j] = xr[64 * j];
            s += (t[j][0] * t[j][0] + t[j][1] * t[j][1]) + (t[j][2] * t[j][2] + t[j][3] * t[j][3]); }
        const float r1 = 1.0f / sqrtf(wave_sum(s) * (1.f / D) + RMS_EPS);
        float s2 = 0.f;
        f32x4* xo = (f32x4*)(xout + (size_t)m * D) + lane;
#pragma unroll
        for (int j = 0; j < 4; ++j) { const f32x4 gv = *((const f32x4*)ga + lane + 64 * j); v[j] = v[j] + t[j] * r1 * gv; xo[64 * j] = v[j];
            s2 += (v[j][0] * v[j][0] + v[j][1] * v[j][1]) + (v[j][2] * v[j][2] + v[j][3] * v[j][3]); }
        if (xn) {
            const float r2 = 1.0f / sqrtf(wave_sum(s2) * (1.f / D) + RMS_EPS);
            u32x2* o = (u32x2*)(xn + (guard ? xn_row(m) : (size_t)m) * D) + lane;
#pragma unroll
            for (int j = 0; j < 4; ++j) { const f32x4 gv = *((const f32x4*)gb + lane + 64 * j); u32x2 w; w.x = pk2(v[j][0] * r2 * gv[0], v[j][1] * r2 * gv[1]); w.y = pk2(v[j][2] * r2 * gv[2], v[j][3] * r2 * gv[3]); o[64 * j] = w; }
        }
    }
}

struct ScanArgs { const bf16_t *R, *K, *V, *VF, *LW, *AG, *GG, *VG; bf16_t* YG; const float *k_k, *k_a, *r_k, *lnw, *lnb; int layer2; };
__device__ __forceinline__ void scan_v1(const ScanArgs& s, LAS unsigned char* lds, int unit0, int ustride, int tid) {
    LAS float* Wd = (LAS float*)lds;
    LAS float* Aa = Wd + 4096;
    LAS float* Bb = Aa + 4096;
    LAS float* Kk = Bb + 4096;
    LAS float* Rr = Kk + 4096;
    LAS float* Vv = Rr + 4096;
    LAS float* Yy = Vv + 4096;
    LAS float* Bn = Yy + 4096;
    const int q8 = tid & 7, hi6 = tid >> 3;
    for (int unit = unit0; unit < BATCH * NH; unit += ustride) {
        const int b = unit >> 4, h = unit & 15, col = h * 64 + 8 * q8;
        float kkw[8], kaw[8], rkw[8], lw_[8], lb_[8];
#pragma unroll
        for (int i = 0; i < 8; ++i) { kkw[i] = s.k_k[col + i]; kaw[i] = s.k_a[col + i]; rkw[i] = s.r_k[col + i]; lw_[i] = s.lnw[col + i]; lb_[i] = s.lnb[col + i]; }
        float S[8];
#pragma unroll
        for (int i = 0; i < 8; ++i) S[i] = 0.f;
        for (int c = 0; c < SEQ / 64; ++c) {
            const size_t off = ((size_t)b * SEQ + c * 64 + hi6) * D + col;
            float gate[8];
            {
                float r[8], k[8], v[8], lw[8], ag[8];
                unpack8(*(const u32x4*)(s.R + off), r); unpack8(*(const u32x4*)(s.K + off), k); unpack8(*(const u32x4*)(s.V + off), v);
                unpack8(*(const u32x4*)(s.LW + off), lw); unpack8(*(const u32x4*)(s.AG + off), ag); unpack8(*(const u32x4*)(s.GG + off), gate);
                if (s.layer2) { float vf[8], vg[8]; unpack8(*(const u32x4*)(s.VF + off), vf); unpack8(*(const u32x4*)(s.VG + off), vg);
#pragma unroll
                    for (int i = 0; i < 8; ++i) v[i] = v[i] + (vf[i] - v[i]) * vg[i]; }
                float kk[8], ss = 0.f, bon = 0.f;
#pragma unroll
                for (int i = 0; i < 8; ++i) { kk[i] = k[i] * kkw[i]; ss += kk[i] * kk[i]; }
                ss = sum8(ss);
                const float inv = 1.0f / fmaxf(sqrtf(ss), 1e-12f);
#pragma unroll
                for (int i = 0; i < 8; ++i) {
                    kk[i] *= inv;
                    const float kp = k[i] * (1.0f + (ag[i] - 1.0f) * kaw[i]);
                    bon += r[i] * kp * rkw[i];
                    const int li = hi6 * 64 + 8 * q8 + i;
                    Wd[li] = __expf(lw[i]); Aa[li] = -kk[i]; Bb[li] = kk[i] * ag[i]; Kk[li] = kp; Rr[li] = r[i]; Vv[li] = v[i];
                }
                bon = sum8(bon);
                if (q8 == 0) Bn[hi6] = bon;
            }
            __syncthreads();
            for (int t = 0; t < 64; ++t) {
                const int li = t * 64 + 8 * q8;
                const f32x4 w0 = *(const LAS f32x4*)(Wd + li), w1 = *(const LAS f32x4*)(Wd + li + 4), a0 = *(const LAS f32x4*)(Aa + li), a1 = *(const LAS f32x4*)(Aa + li + 4);
                const f32x4 b0 = *(const LAS f32x4*)(Bb + li), b1 = *(const LAS f32x4*)(Bb + li + 4), k0 = *(const LAS f32x4*)(Kk + li), k1 = *(const LAS f32x4*)(Kk + li + 4);
                const f32x4 r0 = *(const LAS f32x4*)(Rr + li), r1 = *(const LAS f32x4*)(Rr + li + 4);
                const float vv = Vv[t * 64 + hi6];
                float sa = 0.f;
#pragma unroll
                for (int i = 0; i < 4; ++i) { sa += S[i] * a0[i]; sa += S[4 + i] * a1[i]; }
                sa = sum8(sa);
                float y = 0.f;
#pragma unroll
                for (int i = 0; i < 4; ++i) {
                    S[i] = S[i] * w0[i] + sa * b0[i] + vv * k0[i]; S[4 + i] = S[4 + i] * w1[i] + sa * b1[i] + vv * k1[i];
                    y += S[i] * r0[i]; y += S[4 + i] * r1[i];
                }
                y = sum8(y);
                if (q8 == 0) Yy[t * 64 + hi6] = y;
            }
            __syncthreads();
            {
                float y[8], mu = 0.f, var = 0.f;
#pragma unroll
                for (int i = 0; i < 8; ++i) { y[i] = Yy[hi6 * 64 + 8 * q8 + i]; mu += y[i]; }
                mu = sum8(mu) * (1.f / 64.f);
#pragma unroll
                for (int i = 0; i < 8; ++i) { y[i] -= mu; var += y[i] * y[i]; }
                var = sum8(var) * (1.f / 64.f);
                const float rs = 1.0f / sqrtf(var + GN_EPS), bon = Bn[hi6];
                float o[8];
#pragma unroll
                for (int i = 0; i < 8; ++i) o[i] = (y[i] * rs * lw_[i] + lb_[i] + bon * Vv[hi6 * 64 + 8 * q8 + i]) * gate[i];
                u32x4 w; w.x = pk2(o[0], o[1]); w.y = pk2(o[2], o[3]); w.z = pk2(o[4], o[5]); w.w = pk2(o[6], o[7]);
                *(u32x4*)(s.YG + off) = w;
            }
            __syncthreads();
        }
    }
}

typedef short s16x4 __attribute__((ext_vector_type(4)));
__device__ __forceinline__ s16x4 tr16(const LAS unsigned char* p) { return __builtin_bit_cast(s16x4, __builtin_amdgcn_ds_read_tr16_b64_v4i16((LAS s16x4*)p)); }
__device__ __forceinline__ s16x4 pk4(const f32x4 v) { u32x2 w; w.x = pk2(v[0], v[1]); w.y = pk2(v[2], v[3]); return __builtin_bit_cast(s16x4, w); }
__device__ __forceinline__ f32x4 mfma16(const s16x4 a, const s16x4 b, const f32x4 c) { return __builtin_amdgcn_mfma_f32_16x16x16bf16_1k(a, b, c, 0, 0, 0); }
constexpr int SC_RS = 144;
constexpr int SC_OA = 0, SC_OR = 9216, SC_OB = 18432, SC_OK = 27648, SC_OV = 36864, SC_LWG = 46080, SC_AAB = 62464, SC_TT = 66560, SC_AAK = 68608, SC_ARB = 70656, SC_ARK = 72704,
              SC_GL = 74752, SC_YY = 75776, SC_BN = 92160, SC_END = 92416;
static_assert(SC_END <= 131072, "scan LDS");
__device__ __forceinline__ void scan_v2(const ScanArgs& s, LAS unsigned char* lds, int unit0, int ustride, int tid) {
    const int lane = tid & 63, w = __builtin_amdgcn_readfirstlane(tid >> 6), q8 = tid & 7, t64 = tid >> 3, fr = lane & 15, fq = lane >> 4;
    for (int unit = unit0; unit < BATCH * NH; unit += ustride) {
        const int b = unit >> 4, h = unit & 15, col = h * 64 + 8 * q8;
        f32x4 Hacc[4];
#pragma unroll
        for (int m = 0; m < 4; ++m) Hacc[m] = (f32x4){0.f, 0.f, 0.f, 0.f};
        size_t off = ((size_t)b * SEQ + t64) * D + col;
        u32x4 raw_r = *(const u32x4*)(s.R + off), raw_k = *(const u32x4*)(s.K + off), raw_v = *(const u32x4*)(s.V + off), raw_lw = *(const u32x4*)(s.LW + off),
              raw_ag = *(const u32x4*)(s.AG + off), raw_gg = *(const u32x4*)(s.GG + off), raw_vf = raw_v, raw_vg = raw_v;
        if (s.layer2) { raw_vf = *(const u32x4*)(s.VF + off); raw_vg = *(const u32x4*)(s.VG + off); }
#pragma unroll 1
        for (int mc = 0; mc < SEQ / 64; ++mc) {
            const size_t off_cur = off;
            const u32x4 cur_gg = raw_gg;
            float r[8], kp[8], as_[8], bs_[8], lw[8];
            {
                float k[8], v[8], ag[8];
                unpack8(raw_r, r); unpack8(raw_k, k); unpack8(raw_v, v); unpack8(raw_lw, lw); unpack8(raw_ag, ag);
                if (s.layer2) { float vf[8], vg[8]; unpack8(raw_vf, vf); unpack8(raw_vg, vg);
#pragma unroll
                    for (int i = 0; i < 8; ++i) v[i] = v[i] + (vf[i] - v[i]) * vg[i]; }
                const f32x4 kk0 = *(const f32x4*)(s.k_k + col), kk1 = *(const f32x4*)(s.k_k + col + 4), ka0 = *(const f32x4*)(s.k_a + col), ka1 = *(const f32x4*)(s.k_a + col + 4),
                            rk0 = *(const f32x4*)(s.r_k + col), rk1 = *(const f32x4*)(s.r_k + col + 4);
                float kk[8], ss = 0.f, bon = 0.f;
#pragma unroll
                for (int i = 0; i < 8; ++i) { kk[i] = k[i] * (i < 4 ? kk0[i & 3] : kk1[i & 3]); ss += kk[i] * kk[i]; }
                ss = sum8(ss);
                const float inv = 1.0f / fmaxf(sqrtf(ss), 1e-12f);
#pragma unroll
                for (int i = 0; i < 8; ++i) {
                    const float kn = kk[i] * inv;
                    as_[i] = -kn; bs_[i] = kn * ag[i];
                    kp[i] = k[i] * (1.0f + (ag[i] - 1.0f) * (i < 4 ? ka0[i & 3] : ka1[i & 3]));
                    bon += r[i] * kp[i] * (i < 4 ? rk0[i & 3] : rk1[i & 3]);
                }
                bon = sum8(bon);
                if (q8 == 0) *(LAS float*)(lds + SC_BN + t64 * 4) = bon;
                *(LAS f32x4*)(lds + SC_LWG + (t64 * 64 + 8 * q8) * 4) = (f32x4){lw[0], lw[1], lw[2], lw[3]};
                *(LAS f32x4*)(lds + SC_LWG + (t64 * 64 + 8 * q8 + 4) * 4) = (f32x4){lw[4], lw[5], lw[6], lw[7]};
                u32x4 pv; pv.x = pk2(v[0], v[1]); pv.y = pk2(v[2], v[3]); pv.z = pk2(v[4], v[5]); pv.w = pk2(v[6], v[7]);
                *(LAS u32x4*)(lds + SC_OV + t64 * SC_RS + 16 * q8) = pv;
            }
            __syncthreads();
            if (tid < 256) {
                const int c = tid & 63, sc = tid >> 6; float acc = 0.f;
#pragma unroll
                for (int tl = 0; tl < 16; ++tl) { LAS float* p = (LAS float*)(lds + SC_LWG + ((16 * sc + tl) * 64 + c) * 4); acc += *p; *p = acc; }
                *(LAS float*)(lds + SC_GL + (sc * 64 + c) * 4) = __expf(acc);
            }
            __syncthreads();
            {
                const f32x4 g0 = *(const LAS f32x4*)(lds + SC_LWG + (t64 * 64 + 8 * q8) * 4), g1 = *(const LAS f32x4*)(lds + SC_LWG + (t64 * 64 + 8 * q8 + 4) * 4);
                float oa[8], orr[8], ob[8], ok[8];
#pragma unroll
                for (int i = 0; i < 8; ++i) {
                    const float g = i < 4 ? g0[i & 3] : g1[i & 3];
                    const float ep = __expf(g), epv = __expf(g - lw[i]), en = __expf(-g);
                    oa[i] = as_[i] * epv; orr[i] = r[i] * ep; ob[i] = bs_[i] * en; ok[i] = kp[i] * en;
                }
                u32x4 p;
                p.x = pk2(oa[0], oa[1]); p.y = pk2(oa[2], oa[3]); p.z = pk2(oa[4], oa[5]); p.w = pk2(oa[6], oa[7]); *(LAS u32x4*)(lds + SC_OA + t64 * SC_RS + 16 * q8) = p;
                p.x = pk2(orr[0], orr[1]); p.y = pk2(orr[2], orr[3]); p.z = pk2(orr[4], orr[5]); p.w = pk2(orr[6], orr[7]); *(LAS u32x4*)(lds + SC_OR + t64 * SC_RS + 16 * q8) = p;
                p.x = pk2(ob[0], ob[1]); p.y = pk2(ob[2], ob[3]); p.z = pk2(ob[4], ob[5]); p.w = pk2(ob[6], ob[7]); *(LAS u32x4*)(lds + SC_OB + t64 * SC_RS + 16 * q8) = p;
                p.x = pk2(ok[0], ok[1]); p.y = pk2(ok[2], ok[3]); p.z = pk2(ok[4], ok[5]); p.w = pk2(ok[6], ok[7]); *(LAS u32x4*)(lds + SC_OK + t64 * SC_RS + 16 * q8) = p;
            }
            if (mc + 1 < SEQ / 64) {
                off += (size_t)64 * D;
                raw_r = *(const u32x4*)(s.R + off); raw_k = *(const u32x4*)(s.K + off); raw_v = *(const u32x4*)(s.V + off); raw_lw = *(const u32x4*)(s.LW + off);
                raw_ag = *(const u32x4*)(s.AG + off); raw_gg = *(const u32x4*)(s.GG + off);
                if (s.layer2) { raw_vf = *(const u32x4*)(s.VF + off); raw_vg = *(const u32x4*)(s.VG + off); }
            }
            __syncthreads();
            {
                const int sc = w >> 1, half = w & 1;
                const LAS unsigned char* xrow = lds + (half ? SC_OR : SC_OA) + (16 * sc + fr) * SC_RS + fq * 16;
                const LAS unsigned char* brow = lds + SC_OB + (16 * sc + fr) * SC_RS + fq * 16;
                const LAS unsigned char* krow = lds + SC_OK + (16 * sc + fr) * SC_RS + fq * 16;
                const bf16x8 x0 = *(const LAS bf16x8*)xrow, x1 = *(const LAS bf16x8*)(xrow + 64), b0 = *(const LAS bf16x8*)brow, b1 = *(const LAS bf16x8*)(brow + 64),
                             k0 = *(const LAS bf16x8*)krow, k1 = *(const LAS bf16x8*)(krow + 64);
                f32x4 pb = (f32x4){0.f, 0.f, 0.f, 0.f}, pk = pb;
                pb = __builtin_amdgcn_mfma_f32_16x16x32_bf16(b0, x0, pb, 0, 0, 0); pb = __builtin_amdgcn_mfma_f32_16x16x32_bf16(b1, x1, pb, 0, 0, 0);
                pk = __builtin_amdgcn_mfma_f32_16x16x32_bf16(k0, x0, pk, 0, 0, 0); pk = __builtin_amdgcn_mfma_f32_16x16x32_bf16(k1, x1, pk, 0, 0, 0);
#pragma unroll
                for (int e = 0; e < 4; ++e) { const int jj = 4 * fq + e; const bool keep = half ? (jj <= fr) : (jj < fr); pb[e] = keep ? pb[e] : 0.f; pk[e] = keep ? pk[e] : 0.f; }
                const int eo = sc * 256 + fr * 16 + 4 * fq;
                u32x2 wk; wk.x = pk2(pk[0], pk[1]); wk.y = pk2(pk[2], pk[3]);
                if (!half) { *(LAS f32x4*)(lds + SC_AAB + eo * 4) = pb; *(LAS u32x2*)(lds + SC_AAK + eo * 2) = wk; }
                else { u32x2 wb; wb.x = pk2(pb[0], pb[1]); wb.y = pk2(pb[2], pb[3]); *(LAS u32x2*)(lds + SC_ARB + eo * 2) = wb; *(LAS u32x2*)(lds + SC_ARK + eo * 2) = wk; }
            }
            __syncthreads();
            if (w == 0) {
                float T[16];
#pragma unroll
                for (int t = 0; t < 16; ++t) {
                    float acc = (t == fr) ? 1.f : 0.f;
                    const LAS float* ar = (const LAS float*)(lds + SC_AAB + (fq * 256 + t * 16) * 4);
#pragma unroll
                    for (int j4 = 0; j4 < (t + 3) / 4; ++j4) { const f32x4 a4 = *(const LAS f32x4*)(ar + 4 * j4);
#pragma unroll
                        for (int e = 0; e < 4; ++e) if (4 * j4 + e < t) acc += a4[e] * T[4 * j4 + e]; }
                    T[t] = acc;
                    *(LAS unsigned short*)(lds + SC_TT + (fq * 256 + t * 16 + fr) * 2) = (unsigned short)f2bf(acc);
                }
            }
            __syncthreads();
            if (w < 4) {
                const int qq = (lane >> 2) & 3, p4 = lane & 3;
#pragma unroll 1
                for (int sc = 0; sc < 4; ++sc) {
                    s16x4 hb[4];
#pragma unroll
                    for (int m = 0; m < 4; ++m) hb[m] = pk4(Hacc[m]);
                    const LAS unsigned char* arow = lds + SC_OA + (16 * sc + fr) * SC_RS + fq * 8;
                    const LAS unsigned char* rrow = lds + SC_OR + (16 * sc + fr) * SC_RS + fq * 8;
                    const int eo = (sc * 256 + fr * 16 + 4 * fq) * 2;
                    const s16x4 vfr = tr16(lds + SC_OV + (16 * sc + 4 * fq + qq) * SC_RS + (16 * w + 4 * p4) * 2);
                    f32x4 X = (f32x4){0.f, 0.f, 0.f, 0.f}, Y = X;
#pragma unroll
                    for (int m = 0; m < 4; ++m) { X = mfma16(*(const LAS s16x4*)(arow + 32 * m), hb[m], X); Y = mfma16(*(const LAS s16x4*)(rrow + 32 * m), hb[m], Y); }
                    X = mfma16(*(const LAS s16x4*)(lds + SC_AAK + eo), vfr, X);
                    Y = mfma16(*(const LAS s16x4*)(lds + SC_ARK + eo), vfr, Y);
                    const s16x4 xb = pk4(X);
                    const f32x4 U = mfma16(*(const LAS s16x4*)(lds + SC_TT + eo), xb, (f32x4){0.f, 0.f, 0.f, 0.f});
                    const s16x4 ub = pk4(U);
                    Y = mfma16(*(const LAS s16x4*)(lds + SC_ARB + eo), ub, Y);
#pragma unroll
                    for (int e = 0; e < 4; ++e) *(LAS float*)(lds + SC_YY + ((16 * sc + 4 * fq + e) * 64 + 16 * w + fr) * 4) = Y[e];
#pragma unroll
                    for (int m = 0; m < 4; ++m) {
                        const int toff = (16 * sc + 4 * fq + qq) * SC_RS + (16 * m + 4 * p4) * 2;
                        const s16x4 bt = tr16(lds + SC_OB + toff), kt = tr16(lds + SC_OK + toff);
                        f32x4 hn = mfma16(bt, ub, Hacc[m]); hn = mfma16(kt, vfr, hn);
                        const f32x4 gl = *(const LAS f32x4*)(lds + SC_GL + (sc * 64 + 16 * m + 4 * fq) * 4);
                        Hacc[m] = hn * gl;
                    }
                }
            }
            __syncthreads();
            {
                const f32x4 y0 = *(const LAS f32x4*)(lds + SC_YY + (t64 * 64 + 8 * q8) * 4), y1 = *(const LAS f32x4*)(lds + SC_YY + (t64 * 64 + 8 * q8 + 4) * 4);
                float y[8], vv[8], gate[8], mu = 0.f, var = 0.f;
#pragma unroll
                for (int i = 0; i < 8; ++i) { y[i] = i < 4 ? y0[i & 3] : y1[i & 3]; mu += y[i]; }
                mu = sum8(mu) * (1.f / 64.f);
#pragma unroll
                for (int i = 0; i < 8; ++i) { y[i] -= mu; var += y[i] * y[i]; }
                var = sum8(var) * (1.f / 64.f);
                const float rs = 1.0f / sqrtf(var + GN_EPS), bon = *(const LAS float*)(lds + SC_BN + t64 * 4);
                unpack8(*(const LAS u32x4*)(lds + SC_OV + t64 * SC_RS + 16 * q8), vv); unpack8(cur_gg, gate);
                const f32x4 lw0 = *(const f32x4*)(s.lnw + col), lw1 = *(const f32x4*)(s.lnw + col + 4), lb0 = *(const f32x4*)(s.lnb + col), lb1 = *(const f32x4*)(s.lnb + col + 4);
                float o[8];
#pragma unroll
                for (int i = 0; i < 8; ++i) o[i] = (y[i] * rs * (i < 4 ? lw0[i & 3] : lw1[i & 3]) + (i < 4 ? lb0[i & 3] : lb1[i & 3]) + bon * vv[i]) * gate[i];
                u32x4 wv; wv.x = pk2(o[0], o[1]); wv.y = pk2(o[2], o[3]); wv.z = pk2(o[4], o[5]); wv.w = pk2(o[6], o[7]);
                *(u32x4*)(s.YG + off_cur) = wv;
            }
            __syncthreads();
        }
    }
}

__device__ __forceinline__ int crow(int r, int hi) { return (r & 3) + 8 * (r >> 2) + 4 * hi; }
__device__ __forceinline__ void attn_v1(const bf16_t* Q, const bf16_t* KA, const bf16_t* VA, bf16_t* O, const float* sinks, int gw, int NGW, int lane) {
    const int q = lane & 31, hi = lane >> 5;
    for (int unit = gw; unit < BATCH * NH * (SEQ / 32); unit += NGW) {
        const int qb = unit & 63, hq = (unit >> 6) & 15, b = unit >> 10, kvh = hq >> 2, t0 = qb * 32;
        const size_t rowb = (size_t)b * SEQ;
        bf16x8 qf[4];
#pragma unroll
        for (int ks = 0; ks < 4; ++ks) qf[ks] = *(const bf16x8*)(Q + (rowb + t0 + q) * D + hq * 64 + ks * 16 + hi * 8);
        f32x16 sc[5];
        float mx = sinks[hq] * LOG2E;
        const int qpos = t0 + q;
#pragma unroll
        for (int j = 0; j < 5; ++j) {
            const int kb = t0 - 128 + 32 * j; int kr = kb + q; kr = kr < 0 ? 0 : kr;
            f32x16 s = {};
#pragma unroll
            for (int ks = 0; ks < 4; ++ks) { const bf16x8 kf = *(const bf16x8*)(KA + (rowb + kr) * 256 + kvh * 64 + ks * 16 + hi * 8); s = __builtin_amdgcn_mfma_f32_32x32x16_bf16(kf, qf[ks], s, 0, 0, 0); }
#pragma unroll
            for (int r = 0; r < 16; ++r) { const int kpos = kb + crow(r, hi), rel = qpos - kpos; const bool ok = (kpos >= 0) && (rel >= 0) && (rel < 128); s[r] = ok ? s[r] : -INFINITY; mx = fmaxf(mx, s[r]); }
            sc[j] = s;
        }
        mx = fmaxf(mx, __shfl_xor(mx, 32));
        float l = 0.f;
#pragma unroll
        for (int j = 0; j < 5; ++j)
#pragma unroll
            for (int r = 0; r < 16; ++r) { const float p = exp2f(sc[j][r] - mx); sc[j][r] = p; l += p; }
        l += __shfl_xor(l, 32);
        l += exp2f(sinks[hq] * LOG2E - mx);
        f32x16 o[2]; o[0] = f32x16{}; o[1] = f32x16{};
#pragma unroll
        for (int j = 0; j < 5; ++j) {
            const int kb = t0 - 128 + 32 * j;
#pragma unroll
            for (int s2 = 0; s2 < 2; ++s2) {
                bf16x8 pf;
#pragma unroll
                for (int e = 0; e < 8; ++e) pf[e] = (short)f2bf(sc[j][8 * s2 + e]);
#pragma unroll
                for (int dt = 0; dt < 2; ++dt) {
                    bf16x8 vf;
#pragma unroll
                    for (int e = 0; e < 8; ++e) { int key = kb + 16 * s2 + 8 * (e >> 2) + 4 * hi + (e & 3); key = key < 0 ? 0 : key; vf[e] = (short)VA[(rowb + key) * 256 + kvh * 64 + dt * 32 + q]; }
                    o[dt] = __builtin_amdgcn_mfma_f32_32x32x16_bf16(vf, pf, o[dt], 0, 0, 0);
                }
            }
        }
        const float il = 1.0f / l;
#pragma unroll
        for (int dt = 0; dt < 2; ++dt)
#pragma unroll
            for (int g4 = 0; g4 < 4; ++g4) {
                const int d = dt * 32 + 8 * g4 + 4 * hi;
                u32x2 w; w.x = pk2(o[dt][4 * g4] * il, o[dt][4 * g4 + 1] * il); w.y = pk2(o[dt][4 * g4 + 2] * il, o[dt][4 * g4 + 3] * il);
                *(u32x2*)(O + (rowb + t0 + q) * D + hq * 64 + d) = w;
            }
    }
}

template <class Epi>
__device__ __forceinline__ void run_gemm(LAS unsigned char* lds, const pg8::Gemm& g, int G, const Epi& E, int tid) {
#if USE_PG8
    pg8::StaticOrder S; S.init(g.M, g.N, G, (int)blockIdx.x);
    pg8::gemm_phase<Epi, true, true>(lds + RING_OFF, g, S, E, tid);
#else
    pg8::gemm_simple<Epi>(g, G, (int)blockIdx.x, E, tid);
#endif
}

__global__ void __launch_bounds__(NWAVES * 64, 2) fwd_kernel(Args args) {
    extern __shared__ __attribute__((aligned(16))) unsigned char lds_raw[];
    LAS unsigned char* lds = (LAS unsigned char*)lds_raw;
    volatile LAS unsigned* MISC = (volatile LAS unsigned*)(lds + MISC_OFF);
    const int G = gridDim.x, bx = blockIdx.x;
    const int vcu = (G % 8 == 0) ? (bx % 8) * (G / 8) + bx / 8 : bx;
    const int NGW = G * NWAVES;
    unsigned char* const ws0 = args.ws;
    unsigned* ctl = (unsigned*)(ws0 + WS_CTL);
    const int wave0 = __builtin_amdgcn_readfirstlane((int)threadIdx.x >> 6);
    for (int u = wave0 * 64 + lane_id(); u < (LDS_BYTES - LDSCTL_OFF) / 4; u += NWAVES * 64) ((LAS unsigned*)(lds + LDSCTL_OFF))[u] = 0u;
    __syncthreads();
    XcdBarrier bar; bar.bar = ctl + CW_BAR; bar.x = 0; bar.st = nullptr;
    const int lo = args.ph_lo, hi = args.ph_hi;
    const bool multi = (hi - lo) > 1;
    if (multi) bar = xcd_barrier_post(ctl + CW_BAR, MISC + 8, wave0 == 0 && lane_id() == 0);
    int ph = 0;
#define PH_BEGIN if (ph >= lo && ph < hi) { int tid = wave0 * 64 + lane_id(); asm volatile("" : "+v"(tid)); \
        const __attribute__((address_space(4))) char* kp_ = (const __attribute__((address_space(4))) char*)__builtin_amdgcn_kernarg_segment_ptr(); asm volatile("" : "+s"(kp_)); \
        InTab in = (InTab)kp_; unsigned char* ws = *(unsigned char* const __attribute__((address_space(4)))*)(kp_ + 232); float* X = *(float* const __attribute__((address_space(4)))*)(kp_ + 224); (void)in; (void)ws; (void)X; \
        const float* rope = (const float*)(ws + WS_ROPE); bf16_t* XN = (bf16_t*)(ws + WS_XN); (void)rope; (void)XN; const int lane = tid & 63, wave = wave0; const int gw = vcu * NWAVES + wave; \
        LAS float* scr = (LAS float*)(lds + RING_OFF + wave * 16384); (void)lane; (void)gw; (void)scr;
#define PH_END } if (ph >= lo && ph + 1 < hi) xcd_barrier(bar, wave0 == 0 && lane_id() == 0); ++ph;


    PH_BEGIN
        if (PROBE_PHASE == 4) { cvt_rwkv(in, 0, ws, scr, gw, NGW, lane); cvt_ffn(in, 0, ws, scr, gw, NGW, lane); cvt_attn(in, 0, ws, scr, gw, NGW, lane); cvt_ffn(in, 1, ws, scr, gw, NGW, lane); }
        cvt_rwkv(in, 0, ws, scr, gw, NGW, lane);
        cvt_ffn(in, 0, ws, scr, gw, NGW, lane);
        cvt_attn(in, 0, ws, scr, gw, NGW, lane);
        cvt_ffn(in, 1, ws, scr, gw, NGW, lane);
        for (int e = bx * 512 + tid; e < SEQ * 8; e += G * 512) {
            const int pos = e >> 3, i = e & 7;
            const float inv_freq = (float)exp2(-(double)i * 0.125 * 18.931568569324174);
            const float ang = (float)pos * inv_freq;
            ((float*)(ws + WS_ROPE))[e] = (float)cos((double)ang); ((float*)(ws + WS_ROPE))[SEQ * 8 + e] = (float)sin((double)ang);
        }
        for (int e = bx * 512 + tid; e < BATCH * D / 2; e += G * 512) { const int b = e / (D / 2), c = e % (D / 2); ((unsigned*)(XN + (size_t)b * (SEQ + 1) * D))[c] = 0u; }
        norm_rows(in[I_X], in[I_NORMG], XN, gw, NGW, lane);
    PH_END

    for (int layer = 0; layer < 4; ++layer) {
        const int j = layer >> 1;
        if ((layer & 1) == 0) {
            PH_BEGIN
                pg8::Gemm g{XN, (const bf16_t*)(ws + WS_WBIG), M, NBIG, KBIG, D, KBIG, 2, 1 << 30, 0};
                epi::BigOut E{ws, layer == 0 ? WS_VF : WS_V};
                run_gemm(lds, g, G, E, tid);
            PH_END
            PH_BEGIN
                pg8::Gemm g{(const bf16_t*)(ws + WS_L1), (const bf16_t*)(ws + WS_WL2), M, NL2, KL2, LDL1, KL2, 0, 12, 256};
                epi::L2Out E{ws, (const float*)(ws + WS_BIAS4)};
                run_gemm(lds, g, G, E, tid);
            PH_END
            PH_BEGIN
                ScanArgs s{(const bf16_t*)(ws + WS_R), (const bf16_t*)(ws + WS_K), (const bf16_t*)(ws + (layer == 0 ? WS_VF : WS_V)), (const bf16_t*)(ws + WS_VF), (const bf16_t*)(ws + WS_LW),
                           (const bf16_t*)(ws + WS_AG), (const bf16_t*)(ws + WS_GG), (const bf16_t*)(ws + WS_VG), (bf16_t*)(ws + WS_YG),
                           in[I_KK] + j * D, in[I_KA] + j * D, in[I_RK] + j * D, in[I_LNW] + j * D, in[I_LNB] + j * D, layer == 2 ? 1 : 0};
#ifndef DIS_SCAN
#if SCAN_V2
                scan_v2(s, lds, bx, G, tid);
#else
                scan_v1(s, lds, bx, G, tid);
#endif
#endif
                if (layer == 2) { __syncthreads(); cvt_attn(in, 1, ws, scr, gw, NGW, lane); cvt_ffn(in, 3, ws, scr, gw, NGW, lane); }
            PH_END
            PH_BEGIN
                pg8::Gemm g{(const bf16_t*)(ws + WS_YG), (const bf16_t*)(ws + WS_WOR), M, D, D, D, D, 0, 1 << 30, 0};
                epi::Bf16Out E{(bf16_t*)(ws + WS_TMP), D, nullptr};
                run_gemm(lds, g, G, E, tid);
            PH_END
        } else {
            PH_BEGIN
                pg8::Gemm g{XN, (const bf16_t*)(ws + WS_WQKV), M, NQKV, D, D, D, 1, 1 << 30, 0};
                epi::QkvOut E{ws, (const float*)(ws + WS_BIASQ), rope};
                run_gemm(lds, g, G, E, tid);
            PH_END
            PH_BEGIN
#ifndef DIS_ATTN
                if (PROBE_PHASE == 2 && layer == 1) attn_v1((const bf16_t*)(ws + WS_Q), (const bf16_t*)(ws + WS_KA), (const bf16_t*)(ws + WS_VA), (bf16_t*)(ws + WS_O), in[I_SINK] + j * NH, gw, NGW, lane);
                attn_v1((const bf16_t*)(ws + WS_Q), (const bf16_t*)(ws + WS_KA), (const bf16_t*)(ws + WS_VA), (bf16_t*)(ws + WS_O), in[I_SINK] + j * NH, gw, NGW, lane);
#endif
                if (layer == 1) { cvt_rwkv(in, 1, ws, scr, gw, NGW, lane); cvt_ffn(in, 2, ws, scr, gw, NGW, lane); }
            PH_END
            PH_BEGIN
                pg8::Gemm g{(const bf16_t*)(ws + WS_O), (const bf16_t*)(ws + WS_WOA), M, D, D, D, D, 0, 1 << 30, 0};
                epi::Bf16Out E{(bf16_t*)(ws + WS_TMP), D, in[I_BOA] + (size_t)j * D};
                run_gemm(lds, g, G, E, tid);
            PH_END
        }
        PH_BEGIN
            const float* ng = in[I_NORMG] + (size_t)layer * 4 * D;
            if (PROBE_PHASE == 3 && layer == 0) resnorm_rows((const bf16_t*)(ws + WS_TMP), in[I_X], X, ng + D, ng + 2 * D, (bf16_t*)(ws + WS_XN2), false, gw, NGW, lane);
            resnorm_rows((const bf16_t*)(ws + WS_TMP), (layer == 0) ? in[I_X] : X, X, ng + D, ng + 2 * D, (bf16_t*)(ws + WS_XN2), false, gw, NGW, lane);
        PH_END
        PH_BEGIN
            pg8::Gemm g{(const bf16_t*)(ws + WS_XN2), (const bf16_t*)(ws + ((layer & 1) ? WS_WGU_B : WS_WGU_A)), M, 2 * DFF, D, D, D, 0, 1 << 30, 0};
            epi::SwigluOut E{(bf16_t*)(ws + WS_H)};
            run_gemm(lds, g, G, E, tid);
        PH_END
        PH_BEGIN
            pg8::Gemm g{(const bf16_t*)(ws + WS_H), (const bf16_t*)(ws + ((layer & 1) ? WS_WD_B : WS_WD_A)), M, D, DFF, DFF, DFF, 0, 1 << 30, 0};
            epi::Bf16Out E{(bf16_t*)(ws + WS_TMP), D, nullptr};
            run_gemm(lds, g, G, E, tid);
        PH_END
        PH_BEGIN
            const float* ng = in[I_NORMG] + (size_t)layer * 4 * D;
            resnorm_rows((const bf16_t*)(ws + WS_TMP), X, X, ng + 3 * D, ng + 4 * D, layer < 3 ? XN : nullptr, true, gw, NGW, lane);
        PH_END
    }
#undef PH_BEGIN
#undef PH_END
}

constexpr int N_PHASES = 1 + 2 * 8 + 2 * 7;

extern "C" void kernel_launch(void* const* d_in, const int* in_sizes, int n_in, void* d_out, int out_size, void* d_ws, size_t ws_size, hipStream_t stream) {
    static int grid = 0;
    if (grid == 0) {
        if (n_in != 28 || out_size != M * D || ws_size < WS_END) { fprintf(stderr, "kernel_launch: unexpected shapes (n_in %d out %d ws %zu)\n", n_in, out_size, ws_size); grid = -1; return; }
        int dev = 0, cus = 0;
        if (hipGetDevice(&dev) != hipSuccess || hipDeviceGetAttribute(&cus, hipDeviceAttributeMultiprocessorCount, dev) != hipSuccess) { grid = -1; return; }
        if (hipFuncSetAttribute((const void*)fwd_kernel, hipFuncAttributeMaxDynamicSharedMemorySize, LDS_BYTES) != hipSuccess) { fprintf(stderr, "kernel_launch: hipFuncSetAttribute failed\n"); grid = -1; return; }
        int per_cu = 0;
        if (hipOccupancyMaxActiveBlocksPerMultiprocessor(&per_cu, (const void*)fwd_kernel, NWAVES * 64, LDS_BYTES) != hipSuccess || per_cu < 1) { fprintf(stderr, "kernel_launch: occupancy query says %d\n", per_cu); }
        (void)hipGetLastError();
        grid = cus;
    }
    if (grid < 0) return;
    if (hipMemsetAsync((char*)d_ws + WS_CTL, 0, CTL_ZERO_BYTES, stream) != hipSuccess) return;
    Args a{};
    for (int i = 0; i < 28; ++i) a.in[i] = (const float*)d_in[i];
    a.out = (float*)d_out; a.ws = (unsigned char*)d_ws;
#if MK_N_LAUNCHES == 1
    a.ph_lo = 0; a.ph_hi = N_PHASES;
    hipLaunchKernelGGL(fwd_kernel, dim3(grid), dim3(NWAVES * 64), LDS_BYTES, stream, a);
#else
    for (int p = 0; p < N_PHASES; ++p) { a.ph_lo = p; a.ph_hi = p + 1; hipLaunchKernelGGL(fwd_kernel, dim3(grid), dim3(NWAVES * 64), LDS_BYTES, stream, a); }
#endif
}
```
